# Optimizing an MI355X kernel written in HIP

```python
import math
import jax, jax.numpy as jnp
from jax import lax
import numpy as np

D_MODEL = 1024
BATCH = 4
SEQ = 4096
DEPTH = 1

POOL_WINDOWS = (2, 4, 8, 16)
POOL_GROUPS = len(POOL_WINDOWS)
POOL_GROUP_DIM = D_MODEL // 8
POOL_WIDTH = POOL_GROUPS * POOL_GROUP_DIM
DN_HEAD_DIM = 128
DN_HEADS = D_MODEL // 128
DN_WIDTH = DN_HEADS * DN_HEAD_DIM
CONV_WIDTH = 4
CHUNK = 64
FFN_HIDDEN = ((8 * D_MODEL // 3) + 127) // 128 * 128
N_SUBLAYERS = 3
RMS_EPS = 1e-6
L2_EPS = 1e-6
MIX_IN_SIZES = (POOL_WIDTH, DN_WIDTH, DN_WIDTH, DN_WIDTH, DN_WIDTH, DN_HEADS, DN_HEADS, D_MODEL, D_MODEL)
MIX_IN_WIDTH = int(sum(MIX_IN_SIZES))
MIX_IN_SPLITS = tuple(int(s) for s in np.cumsum(MIX_IN_SIZES)[:-1])

kernel_name = "hybrid_pool_deltanet_macaron_adaln"


def rms_norm(x, g):
    xf = x.astype(jnp.float32)
    xf = xf * lax.rsqrt(jnp.mean(xf * xf, axis=-1, keepdims=True) + RMS_EPS)
    return (xf * g.astype(jnp.float32)).astype(x.dtype)


def l2_normalize(x):
    return x * lax.rsqrt(jnp.sum(x * x, axis=-1, keepdims=True) + L2_EPS)


def modulate(h, shift, scale):
    return h * (1.0 + scale[:, None, :]) + shift[:, None, :]


def swiglu(h, w_in, w_out):
    gate, up = jnp.split(h @ w_in, 2, axis=-1)
    return (jax.nn.silu(gate) * up) @ w_out


def causal_depthwise_conv(x, w):
    C = x.shape[-1]
    return lax.conv_general_dilated(
        x, w[:, None, :].astype(x.dtype), window_strides=(1,),
        padding=[(CONV_WIDTH - 1, 0)],
        dimension_numbers=('NWC', 'WIO', 'NWC'), feature_group_count=C)


def multiscale_pool(xp):
    T = xp.shape[1]
    xf = xp.astype(jnp.float32)
    cs = jnp.cumsum(xf, axis=1)
    pos = jnp.arange(1, T + 1, dtype=jnp.float32)[:, None]
    outs = []
    for gi, w in enumerate(POOL_WINDOWS):
        sl = slice(gi * POOL_GROUP_DIM, (gi + 1) * POOL_GROUP_DIM)
        c_g = cs[..., sl]
        lagged = jnp.pad(c_g, ((0, 0), (w, 0), (0, 0)))[:, :T]
        mean = (c_g - lagged) / jnp.minimum(pos, float(w))
        outs.append(mean - xf[..., sl])
    return jnp.stack(outs, axis=2).astype(xp.dtype)


def gated_delta_rule_chunked(q, k, v, g, beta):
    B, T, H, K = q.shape
    V = v.shape[-1]
    N = T // CHUNK

    def to_chunks(a):
        a = a.reshape((B, N, CHUNK, H) + a.shape[3:])
        return jnp.moveaxis(a, (1, 3), (0, 2))

    qc, kc, vc, bc = to_chunks(q), to_chunks(k), to_chunks(v), to_chunks(beta)
    gc = jnp.cumsum(to_chunks(g), axis=-1)
    causal = jnp.tril(jnp.ones((CHUNK, CHUNK), dtype=bool))
    strict = jnp.tril(jnp.ones((CHUNK, CHUNK), dtype=bool), -1)
    decay = jnp.exp(jnp.where(causal, gc[..., :, None] - gc[..., None, :], -jnp.inf))
    kk = jnp.einsum('nbhik,nbhjk->nbhij', kc, kc)
    a_mat = jnp.where(strict, bc[..., :, None] * kk * decay, 0.0)
    eye = jnp.eye(CHUNK, dtype=q.dtype)
    rhs = jnp.concatenate([bc[..., None] * vc, (bc * jnp.exp(gc))[..., None] * kc], axis=-1)
    sol = lax.linalg.triangular_solve(a_mat + eye, rhs, left_side=True, lower=True,
                                      unit_diagonal=True)
    u, w = sol[..., :V], sol[..., V:]
    qk = jnp.where(causal, jnp.einsum('nbhik,nbhjk->nbhij', qc, kc) * decay, 0.0)
    q_dec = qc * jnp.exp(gc)[..., None]
    g_last = gc[..., -1]
    k_dec = kc * jnp.exp(g_last[..., None] - gc)[..., None]

    def step(S, xs):
        q_i, qk_i, u_i, w_i, k_i, gl_i = xs
        v_new = u_i - jnp.einsum('bhck,bhkv->bhcv', w_i, S)
        o_i = jnp.einsum('bhck,bhkv->bhcv', q_i, S) + jnp.einsum('bhij,bhjv->bhiv', qk_i, v_new)
        S = S * jnp.exp(gl_i)[..., None, None] + jnp.einsum('bhck,bhcv->bhkv', k_i, v_new)
        return S, o_i

    S0 = jnp.zeros((B, H, K, V), dtype=q.dtype)
    _, o = lax.scan(step, S0, (q_dec, qk, u, w, k_dec, g_last))
    return jnp.moveaxis(o, (0, 2), (1, 3)).reshape(B, T, H, V)


def token_mixer(h, mix_w_in, conv_w, a_log, dt_bias, dn_norm_g, pool_w, pool_scale,
                pool_proj, dn_proj, mix_w_out):
    B, T, _ = h.shape
    proj = h @ mix_w_in
    xp, q, k, v, z, b_raw, a_raw, g_pool, g_dn = jnp.split(proj, MIX_IN_SPLITS, axis=-1)

    pooled = multiscale_pool(xp)
    ya = jnp.einsum('btgc,gcd->btgd', pooled, pool_w).reshape(B, T, POOL_WIDTH) * pool_scale
    ya = ya @ pool_proj

    qkv = jax.nn.silu(causal_depthwise_conv(jnp.concatenate([q, k, v], axis=-1), conv_w))
    qkv = qkv.astype(jnp.float32).reshape(B, T, 3, DN_HEADS, DN_HEAD_DIM)
    qh = l2_normalize(qkv[:, :, 0]) * (DN_HEAD_DIM ** -0.5)
    kh = l2_normalize(qkv[:, :, 1])
    vh = qkv[:, :, 2]
    beta = jax.nn.sigmoid(b_raw.astype(jnp.float32))
    g = -jnp.exp(a_log.astype(jnp.float32)) * jax.nn.softplus(
        a_raw.astype(jnp.float32) + dt_bias.astype(jnp.float32))
    o = gated_delta_rule_chunked(qh, kh, vh, g, beta)
    o = rms_norm(o, dn_norm_g).astype(h.dtype).reshape(B, T, DN_WIDTH) * jax.nn.silu(z)
    yb = o @ dn_proj

    merged = jax.nn.sigmoid(g_pool) * ya + jax.nn.sigmoid(g_dn) * yb
    return merged @ mix_w_out


def setup_inputs(seed: int = 0) -> dict:
    key = jax.random.key(seed)
    ks = jax.random.split(key, 20)
    D, L, F = D_MODEL, DEPTH, FFN_HIDDEN

    def nrm(k, shape, fan_in):
        return jax.random.normal(k, shape, jnp.float32) * fan_in ** -0.5

    x = jax.random.normal(ks[0], (BATCH, SEQ, D), jnp.float32)
    c = jax.random.normal(ks[1], (BATCH, D), jnp.float32)
    ada_w = 0.5 * nrm(ks[2], (L, D, N_SUBLAYERS * 3 * D), D)
    ada_b = 0.01 * jax.random.normal(ks[3], (L, N_SUBLAYERS * 3 * D), jnp.float32)
    norm_g = 1.0 + 0.05 * jax.random.normal(ks[4], (L, N_SUBLAYERS, D), jnp.float32)
    ffn1_w_in = nrm(ks[5], (L, D, 2 * F), D)
    ffn1_w_out = nrm(ks[6], (L, F, D), F)
    ffn2_w_in = nrm(ks[7], (L, D, 2 * F), D)
    ffn2_w_out = nrm(ks[8], (L, F, D), F)
    mix_w_in = nrm(ks[9], (L, D, MIX_IN_WIDTH), D)
    conv_w = nrm(ks[10], (L, CONV_WIDTH, 3 * DN_WIDTH), CONV_WIDTH)
    a_log = jnp.log(jax.random.uniform(ks[11], (L, DN_HEADS), jnp.float32, minval=1.0, maxval=16.0))
    dt = jnp.exp(jax.random.uniform(ks[12], (L, DN_HEADS), jnp.float32,
                                    minval=math.log(1e-3), maxval=math.log(1e-1)))
    dt_bias = dt + jnp.log(-jnp.expm1(-dt))
    dn_norm_g = 1.0 + 0.05 * jax.random.normal(ks[13], (L, DN_HEAD_DIM), jnp.float32)
    pool_w = nrm(ks[14], (L, POOL_GROUPS, POOL_GROUP_DIM, POOL_GROUP_DIM), POOL_GROUP_DIM)
    pool_scale = 1.0 + 0.1 * jax.random.normal(ks[15], (L, POOL_WIDTH), jnp.float32)
    pool_proj = nrm(ks[16], (L, POOL_WIDTH, D), POOL_WIDTH)
    dn_proj = nrm(ks[17], (L, DN_WIDTH, D), DN_WIDTH)
    mix_w_out = nrm(ks[18], (L, D, D), D)
    final_g = 1.0 + 0.05 * jax.random.normal(ks[19], (D,), jnp.float32)
    return {"x": x, "c": c, "ada_w": ada_w, "ada_b": ada_b, "norm_g": norm_g,
            "ffn1_w_in": ffn1_w_in, "ffn1_w_out": ffn1_w_out,
            "ffn2_w_in": ffn2_w_in, "ffn2_w_out": ffn2_w_out,
            "mix_w_in": mix_w_in, "conv_w": conv_w, "a_log": a_log, "dt_bias": dt_bias,
            "dn_norm_g": dn_norm_g, "pool_w": pool_w, "pool_scale": pool_scale,
            "pool_proj": pool_proj, "dn_proj": dn_proj, "mix_w_out": mix_w_out,
            "final_g": final_g}


def reference(x, c, ada_w, ada_b, norm_g, ffn1_w_in, ffn1_w_out, ffn2_w_in, ffn2_w_out,
              mix_w_in, conv_w, a_log, dt_bias, dn_norm_g, pool_w, pool_scale, pool_proj,
              dn_proj, mix_w_out, final_g):
    B = x.shape[0]
    for l in range(DEPTH):
        mod = (jax.nn.silu(c) @ ada_w[l] + ada_b[l]).reshape(B, N_SUBLAYERS, 3, D_MODEL)
        shift, scale, gate = mod[:, :, 0], mod[:, :, 1], mod[:, :, 2]

        h = modulate(rms_norm(x, norm_g[l, 0]), shift[:, 0], scale[:, 0])
        x = x + 0.5 * gate[:, 0, None, :] * swiglu(h, ffn1_w_in[l], ffn1_w_out[l])

        h = modulate(rms_norm(x, norm_g[l, 1]), shift[:, 1], scale[:, 1])
        x = x + gate[:, 1, None, :] * token_mixer(
            h, mix_w_in[l], conv_w[l], a_log[l], dt_bias[l], dn_norm_g[l], pool_w[l],
            pool_scale[l], pool_proj[l], dn_proj[l], mix_w_out[l])

        h = modulate(rms_norm(x, norm_g[l, 2]), shift[:, 2], scale[:, 2])
        x = x + 0.5 * gate[:, 2, None, :] * swiglu(h, ffn2_w_in[l], ffn2_w_out[l])
    return rms_norm(x, final_g)
```

```cpp
#include <hip/hip_runtime.h>
#include <cstdio>
#include <cstdint>
namespace pg8 {
#define PG8_LAS __attribute__((address_space(3)))
typedef unsigned short bf16_t;
typedef short bf16x8 __attribute__((ext_vector_type(8)));
typedef float f32x4 __attribute__((ext_vector_type(4)));
typedef unsigned u32x4 __attribute__((ext_vector_type(4)));
constexpr int BM = 256, BK = 64, HALF = 128, HTB = HALF * BK * 2  , STAGE_BYTES = 8 * HTB, NXCD = 8, WGM = 8;

__host__ __device__ __forceinline__ int lds_byte(int r, int c) { const int st = (r >> 4) * 2 + (c >> 5), rr = r & 15, cc = c & 31, ob = rr * 64 + cc * 2; return st * 1024 + (ob ^ (((ob >> 9) & 1) << 5)); }
__host__ __device__ __forceinline__ void stage_rc(int b, int& R, int& C) { const int st = b / 1024, sb = b % 1024, swz = sb ^ (((sb >> 9) & 1) << 5); R = (st >> 1) * 16 + swz / 64; C = (st & 1) * 32 + (swz % 64) / 2; }
__host__ __device__ __forceinline__ int perm32(int rho) { const int n = rho >> 4, i = rho & 15; return 8 * (i >> 2) + 4 * n + (i & 3); }

struct Unit { int pm, pn; };
struct Gemm { const bf16_t* A; const bf16_t* Bt; int M, N, K; };

struct StaticOrder {
    int nM, nN, nwg, G, c;
    __host__ __device__ void init(int M, int N, int G_, int c_) { nM = M / BM; nN = N / BM; nwg = nM * nN; G = G_; c = c_; }
    __host__ __device__ bool next(int i, Unit& u) const {
        const long L = (long)i * G + c; if (L >= nwg) return false;
        int wgid = (int)L; { const int q = nwg / NXCD, r = nwg % NXCD, xcd = wgid % NXCD, off = wgid / NXCD; wgid = (xcd < r ? xcd * (q + 1) : r * (q + 1) + (xcd - r) * q) + off; }
        const int nig = WGM * nN, gid = wgid / nig, fm = gid * WGM, gsz = (nM - fm) < WGM ? (nM - fm) : WGM;
        u.pm = fm + ((wgid % nig) % gsz); u.pn = (wgid % nig) / gsz; return true;
    }
    __device__ __forceinline__ void a_ready(const Unit&) const {}
    __device__ __forceinline__ void done(const Unit&) const {}
};

typedef float f32x2_t __attribute__((ext_vector_type(2))); typedef __bf16 bf16x2_t __attribute__((ext_vector_type(2)));
__device__ __forceinline__ unsigned cvt_pk_bf16(float lo, float hi) { f32x2_t v = {lo, hi}; bf16x2_t b = __builtin_convertvector(v, bf16x2_t); return __builtin_bit_cast(unsigned, b); }
typedef float f32x2 __attribute__((ext_vector_type(2)));
__device__ __forceinline__ f32x2 gelu_pk(f32x2 v) {
    const f32x2 av = __builtin_elementwise_abs(v), d = av * 0.2316418882f + 1.0f;
    f32x2 t; t.x = __builtin_amdgcn_rcpf(d.x); t.y = __builtin_amdgcn_rcpf(d.y);
    f32x2 q = t * 0.5307027145f + (-0.7265760135f); q = q * t + 0.7107068705f; q = q * t + (-0.142248368f); q = q * t + 0.127414796f; q = q * t;
    const f32x2 s = (v * v) * (-0.72134752044f);
    f32x2 e; e.x = __builtin_amdgcn_exp2f(s.x); e.y = __builtin_amdgcn_exp2f(s.y);
    const f32x2 m = v * (q * e), r = v - m;
    f32x2 o; o.x = v.x < 0.f ? m.x : r.x; o.y = v.y < 0.f ? m.y : r.y; return o;
}

template <int ACT  > struct EpiBf16 {
    static constexpr bool PERM = true, AFTER_DRAIN = false; static_assert(ACT == 0 || ACT == 1, "EpiBf16: ACT is 0 (none) or 1 (gelu_pk)");
    bf16_t* O; int ldc; const float* bias; int split_cols; size_t split_stride; float scale0;
    __device__ __forceinline__ void operator()(const f32x4 (&acc)[2][2][4][2], const Unit& u, int wr, int wc, int fr, int fq) const {
        const int row0 = u.pm * BM + wr * 64 + fr; int colt = u.pn * BM; bf16_t* base = O;
        float sc = 1.f; if (split_cols) { const int t = colt / split_cols; base += (size_t)t * split_stride; colt -= t * split_cols; if (t == 0) sc = scale0; }
        const int col0 = colt + wc * 32 + 8 * fq, bcol0 = u.pn * BM + wc * 32 + 8 * fq;
        f32x4 bv[2][2];
#pragma unroll
        for (int bj = 0; bj < 2; ++bj)
#pragma unroll
            for (int n = 0; n < 2; ++n) bv[bj][n] = bias ? *(const f32x4*)(bias + bcol0 + bj * HALF + 4 * n) : (f32x4){0.f, 0.f, 0.f, 0.f};
#pragma unroll
        for (int ai = 0; ai < 2; ++ai)
#pragma unroll
            for (int m = 0; m < 4; ++m) { bf16_t* rowp = base + (size_t)(row0 + ai * HALF + m * 16) * ldc + col0;
#pragma unroll
                for (int bj = 0; bj < 2; ++bj) { f32x4 v0 = acc[ai][bj][m][0] + bv[bj][0], v1 = acc[ai][bj][m][1] + bv[bj][1];
                    if (ACT == 1) { f32x2 a = gelu_pk((f32x2){v0[0], v0[1]}), b = gelu_pk((f32x2){v0[2], v0[3]}), c = gelu_pk((f32x2){v1[0], v1[1]}), d = gelu_pk((f32x2){v1[2], v1[3]});
                        v0 = (f32x4){a.x, a.y, b.x, b.y}; v1 = (f32x4){c.x, c.y, d.x, d.y}; }
                    v0 = v0 * sc; v1 = v1 * sc; u32x4 w; w.x = cvt_pk_bf16(v0[0], v0[1]); w.y = cvt_pk_bf16(v0[2], v0[3]); w.z = cvt_pk_bf16(v1[0], v1[1]); w.w = cvt_pk_bf16(v1[2], v1[3]);
                    *(u32x4*)(rowp + bj * HALF) = w; } }
    }
};

struct PanelStats {
    unsigned* xbuf;
    unsigned* cnt;
    unsigned* tmo;
    int ntn; float eps;
    unsigned code;
    __device__ __forceinline__ bool run(const f32x4 (&v)[2][2][4][2], const Unit& u, int wr, int wc, int fr, int fq, PG8_LAS unsigned char* lds, int wid, int lane) const {
        typedef float f32x2v __attribute__((ext_vector_type(2)));
        PG8_LAS f32x2v* P = (PG8_LAS f32x2v*)lds;
        PG8_LAS f32x2v* S = (PG8_LAS f32x2v*)(lds + 8192);
        PG8_LAS unsigned* flag = (PG8_LAS unsigned*)(lds + 8192 + 2048);
#pragma unroll
        for (int ai = 0; ai < 2; ++ai)
#pragma unroll
            for (int m = 0; m < 4; ++m) {
                float s = 0.f;
#pragma unroll
                for (int bj = 0; bj < 2; ++bj)
#pragma unroll
                    for (int n = 0; n < 2; ++n) { const f32x4 x = v[ai][bj][m][n]; s += (x[0] + x[1]) + (x[2] + x[3]); }
                s += __shfl_xor(s, 16); s += __shfl_xor(s, 32);
                const float mw = s * (1.0f / 64.0f); float q = 0.f;
#pragma unroll
                for (int bj = 0; bj < 2; ++bj)
#pragma unroll
                    for (int n = 0; n < 2; ++n) { const f32x4 d = v[ai][bj][m][n] - mw; q += (d[0] * d[0] + d[1] * d[1]) + (d[2] * d[2] + d[3] * d[3]); }
                q += __shfl_xor(q, 16); q += __shfl_xor(q, 32);
                if (fq == 0) P[(ai * HALF + wr * 64 + m * 16 + fr) * 4 + wc] = (f32x2v){mw, q};
            }
        asm volatile("s_waitcnt lgkmcnt(0)" ::: "memory"); __builtin_amdgcn_s_barrier(); asm volatile("" ::: "memory");
#if defined(BROKEN_EXCHANGE_NO_WAIT)
#warning BROKEN CONTROL BUILD: the row-statistics exchange does not wait; results are wrong by design
        if (blockIdx.x >= 64) { const long long t0_ = clock64(); while (clock64() - t0_ < 60000) __builtin_amdgcn_s_sleep(8); }
#endif
        const int row = wid * 32 + (lane & 31);
        if (lane < 32) {
            const f32x2v a = P[row * 4 + 0], b = P[row * 4 + 1], c = P[row * 4 + 2], d = P[row * 4 + 3];
            const float mt = (a.x + b.x + c.x + d.x) * 0.25f;
            const float da = a.x - mt, db = b.x - mt, dc = c.x - mt, dd = d.x - mt;
            const float m2 = (a.y + b.y) + (c.y + d.y) + 64.0f * ((da * da + db * db) + (dc * dc + dd * dd));
            unsigned long long* slot = (unsigned long long*)xbuf + ((size_t)(u.pm * BM + row) * 4 + u.pn);
            __hip_atomic_store(slot, ((unsigned long long)__float_as_uint(m2) << 32) | __float_as_uint(mt), __ATOMIC_RELAXED, __HIP_MEMORY_SCOPE_AGENT);
        }
        asm volatile("s_waitcnt vmcnt(0)" ::: "memory");
        if (lane == 0) __hip_atomic_fetch_add(cnt + 64 * u.pm, 1u, __ATOMIC_RELAXED, __HIP_MEMORY_SCOPE_AGENT);
        if (wid == 0) {
            bool dead = false; const unsigned long long t0 = __builtin_amdgcn_s_memrealtime(); const unsigned want = 8u * (unsigned)ntn;
            for (;;) {
#if defined(BROKEN_EXCHANGE_NO_WAIT)
                break;
#endif
                if ((unsigned)__builtin_amdgcn_readfirstlane(__hip_atomic_load(cnt + 64 * u.pm, __ATOMIC_RELAXED, __HIP_MEMORY_SCOPE_AGENT)) >= want) break;
                if (__builtin_amdgcn_s_memrealtime() - t0 > 2000000ull) {
                    if (lane == 0) { unsigned expect = 0u; __hip_atomic_compare_exchange_strong(tmo + 1, &expect, code | (unsigned)(u.pm & 0xff), __ATOMIC_RELAXED, __ATOMIC_RELAXED, __HIP_MEMORY_SCOPE_AGENT);
                                     __hip_atomic_store(tmo, 1u, __ATOMIC_RELAXED, __HIP_MEMORY_SCOPE_AGENT); }
                    dead = true; break; }
                __builtin_amdgcn_s_sleep(2);
            }
            __builtin_amdgcn_fence(__ATOMIC_ACQUIRE, "agent");
            if (lane == 0) flag[0] = dead ? 1u : 0u;
        }
        asm volatile("s_waitcnt vmcnt(0) lgkmcnt(0)" ::: "memory"); __builtin_amdgcn_s_barrier(); asm volatile("" ::: "memory");
        const bool bad = flag[0] != 0u;
        if (lane < 32) {
            const unsigned long long* slot = (const unsigned long long*)xbuf + (size_t)(u.pm * BM + row) * 4; float mt[4], m2[4]; float ms = 0.f;
#pragma unroll
            for (int t = 0; t < 4; ++t) { if (t < ntn) { const unsigned long long w = __hip_atomic_load(slot + t, __ATOMIC_RELAXED, __HIP_MEMORY_SCOPE_AGENT); mt[t] = __uint_as_float((unsigned)w); m2[t] = __uint_as_float((unsigned)(w >> 32)); } else { mt[t] = 0.f; m2[t] = 0.f; } ms += mt[t]; }
            const float mean = ms / (float)ntn; float q = 0.f;
#pragma unroll
            for (int t = 0; t < 4; ++t) if (t < ntn) { const float dm = mt[t] - mean; q += m2[t] + 256.0f * dm * dm; }
            S[row] = (f32x2v){mean, 1.0f / sqrtf(q / (256.0f * (float)ntn) + eps)};
        }
        asm volatile("s_waitcnt lgkmcnt(0)" ::: "memory"); __builtin_amdgcn_s_barrier(); asm volatile("" ::: "memory");
        return bad;
    }
};
struct EpiLnRes {
    static constexpr bool PERM = false, AFTER_DRAIN = true;
    const float* base; float* out; int ldc; const float* bias; PanelStats st; unsigned poison;
    __device__ __forceinline__ void fused(f32x4 (&acc)[2][2][4][2], const Unit& u, int wr, int wc, int fr, int fq, PG8_LAS unsigned char* lds, int wid, int lane) const {
        typedef float f32x2v __attribute__((ext_vector_type(2)));
        const PG8_LAS f32x2v* S = (const PG8_LAS f32x2v*)(lds + 8192);
        const int col0 = u.pn * BM + wc * 32 + 4 * fq;
#pragma unroll
        for (int bj = 0; bj < 2; ++bj)
#pragma unroll
            for (int n = 0; n < 2; ++n) { const f32x4 bv = bias ? *(const f32x4*)(bias + col0 + bj * HALF + n * 16) : (f32x4){0.f, 0.f, 0.f, 0.f};
#pragma unroll
                for (int ai = 0; ai < 2; ++ai)
#pragma unroll
                    for (int m = 0; m < 4; ++m) acc[ai][bj][m][n] += bv; }
        f32x4 pre[4][2][2];
#pragma unroll
        for (int m = 0; m < 4; ++m) { const size_t off = (size_t)(u.pm * BM + wr * 64 + m * 16 + fr) * ldc + col0;
#pragma unroll
            for (int bj = 0; bj < 2; ++bj)
#pragma unroll
                for (int n = 0; n < 2; ++n) pre[m][bj][n] = *(const f32x4*)(base + off + bj * HALF + n * 16); }
        const bool bad = st.run(acc, u, wr, wc, fr, fq, lds, wid, lane) || poison != 0u;
        const float qnan = __builtin_nanf("");
#pragma unroll
        for (int ai = 0; ai < 2; ++ai)
#pragma unroll
            for (int m = 0; m < 4; ++m) { const int r = ai * HALF + wr * 64 + m * 16 + fr; const f32x2v sr = S[r]; const size_t off = (size_t)(u.pm * BM + r) * ldc + col0;
#pragma unroll
                for (int bj = 0; bj < 2; ++bj)
#pragma unroll
                    for (int n = 0; n < 2; ++n) { const f32x4 bs = ai == 0 ? pre[m][bj][n] : *(const f32x4*)(base + off + bj * HALF + n * 16); f32x4 o = bs + (acc[ai][bj][m][n] - sr.x) * sr.y;
                        if (bad) o = (f32x4){qnan, qnan, qnan, qnan}; *(f32x4*)(out + off + bj * HALF + n * 16) = o; }
                if (m & 1) asm volatile("" ::: "memory"); }
    }
};
struct EpiLnResLn {
    static constexpr bool PERM = false, AFTER_DRAIN = true;
    const float* base; float* out; bf16_t* xn; int ldc; const float* bias; PanelStats st1, st2; unsigned poison;
    __device__ __forceinline__ void fused(f32x4 (&acc)[2][2][4][2], const Unit& u, int wr, int wc, int fr, int fq, PG8_LAS unsigned char* lds, int wid, int lane) const {
        typedef float f32x2v __attribute__((ext_vector_type(2))); typedef unsigned u32x2v __attribute__((ext_vector_type(2)));
        const PG8_LAS f32x2v* S = (const PG8_LAS f32x2v*)(lds + 8192);
        const int col0 = u.pn * BM + wc * 32 + 4 * fq;
#pragma unroll
        for (int bj = 0; bj < 2; ++bj)
#pragma unroll
            for (int n = 0; n < 2; ++n) { const f32x4 bv = bias ? *(const f32x4*)(bias + col0 + bj * HALF + n * 16) : (f32x4){0.f, 0.f, 0.f, 0.f};
#pragma unroll
                for (int ai = 0; ai < 2; ++ai)
#pragma unroll
                    for (int m = 0; m < 4; ++m) acc[ai][bj][m][n] += bv; }
        bool bad = st1.run(acc, u, wr, wc, fr, fq, lds, wid, lane) || poison != 0u;
        const float qnan = __builtin_nanf("");
#pragma unroll
        for (int ai = 0; ai < 2; ++ai)
#pragma unroll
            for (int m = 0; m < 4; ++m) { const int r = ai * HALF + wr * 64 + m * 16 + fr; const f32x2v sr = S[r]; const size_t off = (size_t)(u.pm * BM + r) * ldc + col0;
#pragma unroll
                for (int bj = 0; bj < 2; ++bj)
#pragma unroll
                    for (int n = 0; n < 2; ++n) { const f32x4 bs = *(const f32x4*)(base + off + bj * HALF + n * 16); acc[ai][bj][m][n] = bs + (acc[ai][bj][m][n] - sr.x) * sr.y; }
                asm volatile("" : "+v"(acc[ai][0][m][0]), "+v"(acc[ai][0][m][1]), "+v"(acc[ai][1][m][0]), "+v"(acc[ai][1][m][1]));
                if (m & 1) asm volatile("" ::: "memory"); }
        const bool bad1 = bad;
        bad = st2.run(acc, u, wr, wc, fr, fq, lds, wid, lane) || bad;
#pragma unroll
        for (int ai = 0; ai < 2; ++ai)
#pragma unroll
            for (int m = 0; m < 4; ++m) { const int r = ai * HALF + wr * 64 + m * 16 + fr; const f32x2v sr = S[r]; const size_t off = (size_t)(u.pm * BM + r) * ldc + col0;
#pragma unroll
                for (int bj = 0; bj < 2; ++bj)
#pragma unroll
                    for (int n = 0; n < 2; ++n) { const f32x4 x1 = acc[ai][bj][m][n]; *(f32x4*)(out + off + bj * HALF + n * 16) = bad1 ? (f32x4){qnan, qnan, qnan, qnan} : x1;
                        const f32x4 o = (x1 - sr.x) * sr.y; u32x2v w; w.x = cvt_pk_bf16(o[0], o[1]); w.y = cvt_pk_bf16(o[2], o[3]);
                        if (bad) { w.x = 0x7fc07fc0u; w.y = 0x7fc07fc0u; } *(u32x2v*)(xn + off + bj * HALF + n * 16) = w; }
                asm volatile("" ::: "memory"); }
    }
};

template <class Epi, class Sched, bool ALIGN_EPI = false, bool SP2 = false>
__device__ __forceinline__ void gemm_phase(PG8_LAS unsigned char* lds, const Gemm g, const Sched& S, const Epi& E) {
    const int tid = threadIdx.x, wid = __builtin_amdgcn_readfirstlane(tid >> 6), lane = tid & 63, wr = wid >> 2, wc = wid & 3, fr = lane & 15, fq = lane >> 4;
    const int K = g.K, nt = K / BK;
    unsigned voffA[2], voffB[2];
#pragma unroll
    for (int i = 0; i < 2; ++i) { int R, C; stage_rc(tid * 16 + i * 8192, R, C); const int Rb = Epi::PERM ? ((R & ~31) + perm32(R & 31)) : R;
        voffA[i] = (unsigned)(R * K + C) * 2u; voffB[i] = (unsigned)(Rb * K + C) * 2u; }
    const size_t kstep = (size_t)(BK * 2);
    const size_t hstep = (size_t)HALF * K * 2;
    const size_t tstep = 2 * hstep;
    const unsigned ldsw = (unsigned)wid * 1024u;
    const int aoff = lds_byte(wr * 64 + fr, fq * 8), boff = lds_byte(wc * 32 + fr, fq * 8);
#define PG8_SA(b, h) (((b) * 2 + (h)) * HTB)
#define PG8_SB(b, h) ((4 + (b) * 2 + (h)) * HTB)
#define PG8_STAGE(bufoff, gbase, voff) do { _Pragma("unroll") for (int _i = 0; _i < 2; ++_i) \
        __builtin_amdgcn_global_load_lds((const unsigned*)((const char*)(gbase) + (voff)[_i]), (PG8_LAS unsigned*)(lds + (bufoff) + ldsw + _i * 8192), 16, 0, 0); } while (0)
#define PG8_LDA(dst, b, h) do { _Pragma("unroll") for (int m = 0; m < 4; ++m) _Pragma("unroll") for (int k = 0; k < 2; ++k) dst[m][k] = *(const PG8_LAS bf16x8*)(lds + PG8_SA(b, h) + aoff + m * 2048 + k * 1024); } while (0)
#define PG8_LDB(dst, b, h) do { _Pragma("unroll") for (int n = 0; n < 2; ++n) _Pragma("unroll") for (int k = 0; k < 2; ++k) dst[n][k] = *(const PG8_LAS bf16x8*)(lds + PG8_SB(b, h) + boff + n * 2048 + k * 1024); } while (0)
#define PG8_MMA(ai, bj, At, Bt) do { __builtin_amdgcn_s_setprio(1); _Pragma("unroll") for (int m = 0; m < 4; ++m) _Pragma("unroll") for (int n = 0; n < 2; ++n) _Pragma("unroll") for (int k = 0; k < 2; ++k) \
        acc[ai][bj][m][n] = __builtin_amdgcn_mfma_f32_16x16x32_bf16(Bt[n][k], At[m][k], acc[ai][bj][m][n], 0, 0, 0); __builtin_amdgcn_s_setprio(0); } while (0)
#define PG8_WAIT_V(n) asm volatile("s_waitcnt vmcnt(" #n ")" ::: "memory")
#define PG8_WAIT_L(n) asm volatile("s_waitcnt lgkmcnt(" #n ")" ::: "memory")
#define PG8_BAR __builtin_amdgcn_s_barrier()
#define PG8_SCHED __builtin_amdgcn_sched_barrier(0)
    Unit cur, nxt; int ui = 0;
    if (!S.next(0, cur)) return;
    f32x4 acc[2][2][4][2];
#pragma unroll
    for (int a = 0; a < 2; ++a)
#pragma unroll
        for (int b = 0; b < 2; ++b)
#pragma unroll
            for (int m = 0; m < 4; ++m)
#pragma unroll
                for (int n = 0; n < 2; ++n) acc[a][b][m][n] = (f32x4){0.f, 0.f, 0.f, 0.f};
    bf16x8 At[4][2], B0[2][2], B1[2][2];
    const char* cA = (const char*)g.A + (size_t)cur.pm * tstep; const char* cB = (const char*)g.Bt + (size_t)cur.pn * tstep;
    S.a_ready(cur);
    if constexpr (SP2) {
        PG8_STAGE(PG8_SB(0, 0), cB, voffB); PG8_STAGE(PG8_SB(0, 1), cB + hstep, voffB); PG8_STAGE(PG8_SA(0, 0), cA, voffA); PG8_STAGE(PG8_SA(0, 1), cA + hstep, voffA);
        if (wr == 1) PG8_BAR;
        PG8_WAIT_V(2); PG8_BAR;
        PG8_STAGE(PG8_SB(1, 0), cB + kstep, voffB); PG8_STAGE(PG8_SA(1, 0), cA + kstep, voffA); PG8_STAGE(PG8_SB(1, 1), cB + hstep + kstep, voffB);
        PG8_WAIT_V(6); PG8_BAR;
    } else {
        PG8_STAGE(PG8_SB(0, 0), cB, voffB); PG8_STAGE(PG8_SA(0, 0), cA, voffA); PG8_STAGE(PG8_SB(0, 1), cB + hstep, voffB); PG8_STAGE(PG8_SA(0, 1), cA + hstep, voffA);
        if (wr == 1) PG8_BAR;
        PG8_WAIT_V(4); PG8_BAR;
        PG8_STAGE(PG8_SB(1, 0), cB + kstep, voffB); PG8_STAGE(PG8_SA(1, 0), cA + kstep, voffA); PG8_STAGE(PG8_SB(1, 1), cB + hstep + kstep, voffB);
        PG8_WAIT_V(6); PG8_BAR;
    }
    for (;;) {
        const bool has_next = S.next(ui + 1, nxt);
        const char* nA = has_next ? (const char*)g.A + (size_t)nxt.pm * tstep : cA; const char* nB = has_next ? (const char*)g.Bt + (size_t)nxt.pn * tstep : cB;
        for (int t = 0; t < nt; t += 2) {
            const bool last = (t == nt - 2);
            const char* a1 = cA + (size_t)(t + 1) * kstep;
            const char* a2 = last ? nA : cA + (size_t)(t + 2) * kstep; const char* b2 = last ? nB : cB + (size_t)(t + 2) * kstep;
            const char* a3 = a2 + kstep; const char* b3 = b2 + kstep;
            if (last && has_next) S.a_ready(nxt);
            if constexpr (SP2) {
            PG8_LDB(B0, 0, 0); PG8_LDB(B1, 0, 1); PG8_SCHED; PG8_LDA(At, 0, 0); PG8_STAGE(PG8_SA(1, 1), a1 + hstep, voffA);
            PG8_WAIT_V(8); PG8_WAIT_L(0); PG8_BAR; PG8_MMA(0, 0, At, B0); PG8_MMA(0, 1, At, B1); PG8_BAR; PG8_SCHED;
            PG8_LDA(At, 0, 1); PG8_STAGE(PG8_SB(0, 0), b2, voffB); PG8_STAGE(PG8_SB(0, 1), b2 + hstep, voffB); PG8_STAGE(PG8_SA(0, 0), a2, voffA);
            PG8_WAIT_V(8); PG8_WAIT_L(0); PG8_BAR; PG8_MMA(1, 0, At, B0); PG8_MMA(1, 1, At, B1); PG8_BAR; PG8_SCHED;
            PG8_LDB(B0, 1, 0); PG8_LDB(B1, 1, 1); PG8_SCHED; PG8_LDA(At, 1, 0); PG8_STAGE(PG8_SA(0, 1), a2 + hstep, voffA);
            PG8_WAIT_V(8); PG8_WAIT_L(0); PG8_BAR; PG8_MMA(0, 0, At, B0); PG8_MMA(0, 1, At, B1); PG8_BAR; PG8_SCHED;
            PG8_LDA(At, 1, 1); PG8_STAGE(PG8_SB(1, 0), b3, voffB); PG8_STAGE(PG8_SB(1, 1), b3 + hstep, voffB); PG8_STAGE(PG8_SA(1, 0), a3, voffA);
            PG8_WAIT_V(8); PG8_WAIT_L(0); PG8_BAR; PG8_MMA(1, 0, At, B0); PG8_MMA(1, 1, At, B1); PG8_BAR; PG8_SCHED;
            } else {
            PG8_LDB(B0, 0, 0); PG8_SCHED; PG8_LDA(At, 0, 0); PG8_STAGE(PG8_SA(1, 1), a1 + hstep, voffA);
            PG8_WAIT_L(8); PG8_BAR; PG8_WAIT_L(0); PG8_MMA(0, 0, At, B0); PG8_BAR; PG8_SCHED;
            PG8_LDB(B1, 0, 1); PG8_STAGE(PG8_SB(0, 0), b2, voffB);
            PG8_BAR; PG8_WAIT_L(0); PG8_MMA(0, 1, At, B1); PG8_BAR;
            PG8_LDA(At, 0, 1); PG8_STAGE(PG8_SA(0, 0), a2, voffA);
            PG8_BAR; PG8_WAIT_L(0); PG8_MMA(1, 0, At, B0); PG8_BAR; PG8_SCHED;
            PG8_STAGE(PG8_SB(0, 1), b2 + hstep, voffB);
            PG8_WAIT_V(6); PG8_BAR; PG8_MMA(1, 1, At, B1); PG8_BAR;
            PG8_LDB(B0, 1, 0); PG8_SCHED; PG8_LDA(At, 1, 0); PG8_STAGE(PG8_SA(0, 1), a2 + hstep, voffA);
            PG8_WAIT_L(8); PG8_BAR; PG8_WAIT_L(0); PG8_MMA(0, 0, At, B0); PG8_BAR; PG8_SCHED;
            PG8_LDB(B1, 1, 1); PG8_STAGE(PG8_SB(1, 0), b3, voffB);
            PG8_BAR; PG8_WAIT_L(0); PG8_MMA(0, 1, At, B1); PG8_BAR;
            PG8_LDA(At, 1, 1); PG8_STAGE(PG8_SA(1, 0), a3, voffA);
            PG8_BAR; PG8_WAIT_L(0); PG8_MMA(1, 0, At, B0); PG8_BAR; PG8_SCHED;
            PG8_STAGE(PG8_SB(1, 1), b3 + hstep, voffB);
            PG8_WAIT_V(6); PG8_BAR; PG8_MMA(1, 1, At, B1); PG8_BAR;
            }
        }
        if constexpr (ALIGN_EPI) { if (wr == 0) PG8_BAR; }
        if constexpr (!Epi::AFTER_DRAIN) { E(acc, cur, wr, wc, fr, fq); S.done(cur); }
        if (!has_next) break;
#pragma unroll
        for (int a = 0; a < 2; ++a)
#pragma unroll
            for (int b = 0; b < 2; ++b)
#pragma unroll
                for (int m = 0; m < 4; ++m)
#pragma unroll
                    for (int n = 0; n < 2; ++n) acc[a][b][m][n] = (f32x4){0.f, 0.f, 0.f, 0.f};
        cur = nxt; cA = nA; cB = nB; ++ui;
        if constexpr (ALIGN_EPI) { if (wr == 1) PG8_BAR; }
    }
    PG8_WAIT_V(0);
    if constexpr (!ALIGN_EPI) { if (wr == 0) PG8_BAR; }
    PG8_BAR;
    if constexpr (Epi::AFTER_DRAIN) { E.fused(acc, cur, wr, wc, fr, fq, lds, wid, lane); S.done(cur); }
#undef PG8_SA
#undef PG8_SB
#undef PG8_STAGE
#undef PG8_LDA
#undef PG8_LDB
#undef PG8_MMA
#undef PG8_WAIT_V
#undef PG8_WAIT_L
#undef PG8_BAR
#undef PG8_SCHED
}
}

#ifndef PG8_SP2
#define PG8_SP2 true
#endif
#ifndef PG8_ALIGN
#define PG8_ALIGN true
#endif

constexpr int NWAVES = 8;
constexpr int BATCH = 4, T = 4096, D = 1024, M = BATCH * T;
constexpr int FF = 2816, NFF_IN = 2 * FF;
constexpr int POOLW = 512, DNW = 1024, NH = 8, HD = 128;
constexpr int MIXW = 6672;
constexpr int NM1 = 3840;
constexpr int NMOD = 9216;
constexpr float RMS_EPS = 1e-6f, L2_EPS = 1e-6f;

constexpr size_t MiB = 1u << 20;
constexpr size_t WS_CTL = 0, CTL_ZERO_BYTES = 1 * MiB;
constexpr size_t WS_W1IN = 1 * MiB;
constexpr size_t WS_W1OUT = 12 * MiB;
constexpr size_t WS_W2IN = WS_W1OUT + 5632 * 1024;
constexpr size_t WS_W2OUT = WS_W2IN + 11 * MiB;
constexpr size_t WS_WM1 = WS_W2OUT + 5632 * 1024;
constexpr size_t WS_WZ = WS_WM1 + (size_t)NM1 * 1024 * 2;
constexpr size_t WS_WG = WS_WZ + 2 * MiB;
constexpr size_t WS_WPP = WS_WG + 4 * MiB;
constexpr size_t WS_WDN = WS_WPP + 1 * MiB;
constexpr size_t WS_WMO2 = WS_WDN + 2 * MiB;
constexpr size_t WS_MOD = WS_WMO2 + 4 * MiB;
constexpr size_t WS_BIG = 56 * MiB;
constexpr size_t WS_H = 224 * MiB;
constexpr size_t WS_END = 256 * MiB;
constexpr size_t WS_HID = WS_BIG;
constexpr size_t WS_QKV = WS_BIG;
constexpr size_t WS_XP = WS_QKV + 96 * MiB;
constexpr size_t WS_POOLED = WS_XP + 16 * MiB;
constexpr size_t WS_ONORM = WS_POOLED + 16 * MiB;
constexpr size_t WS_BETA = WS_ONORM + 32 * MiB;
constexpr size_t WS_GL = WS_BETA + MiB / 2;
constexpr size_t WS_GATES = WS_BIG;
constexpr size_t WS_OG = WS_GATES + 64 * MiB;
constexpr size_t WS_WPP32 = WS_XP;
constexpr size_t WS_TAB = WS_ONORM;
static_assert(WS_MOD + 4 * 9216 * 4 <= WS_BIG && WS_GL + MiB / 2 <= WS_H && WS_TAB + 64 * MiB <= WS_END && WS_HID + 88 * MiB <= WS_H, "d_ws map");

constexpr int RING_OFF = 0, RING_BYTES = 131072;
constexpr int LDSCTL_OFF = RING_BYTES, MISC_OFF = LDSCTL_OFF + 320;
constexpr int LDS_BYTES = 147456;

#define GAS __attribute__((address_space(1)))
#define LAS __attribute__((address_space(3)))
typedef unsigned short bf16;
typedef unsigned v4u __attribute__((ext_vector_type(4)));
typedef unsigned v2u __attribute__((ext_vector_type(2)));
typedef float f32x4 __attribute__((ext_vector_type(4)));
#define LDS_WAIT() asm volatile("s_waitcnt lgkmcnt(0)" ::: "memory")
#define VM_WAIT() asm volatile("s_waitcnt vmcnt(0)" ::: "memory")
__device__ __forceinline__ unsigned f2bf(float f) { unsigned u = __builtin_bit_cast(unsigned, f); return (u + 0x7fffu + ((u >> 16) & 1u)) >> 16; }
__device__ __forceinline__ unsigned pk2(float lo, float hi) { return f2bf(lo) | (f2bf(hi) << 16); }
__device__ __forceinline__ float bf2f(unsigned short b) { return __builtin_bit_cast(float, (unsigned)b << 16); }
__device__ __forceinline__ float bflo(unsigned w) { return __builtin_bit_cast(float, w << 16); }
__device__ __forceinline__ float bfhi(unsigned w) { return __builtin_bit_cast(float, w & 0xffff0000u); }
__device__ __forceinline__ float fast_sigmoid(float x) { return __builtin_amdgcn_rcpf(1.0f + __builtin_amdgcn_exp2f(-1.4426950408889634f * x)); }
__device__ __forceinline__ float fast_silu(float x) { return x * fast_sigmoid(x); }
__device__ __forceinline__ float wave_sum(float v) {
#pragma unroll
    for (int o = 1; o < 64; o <<= 1) v += __shfl_xor(v, o);
    return v;
}

namespace pg8 {
struct EpiSwiglu {
    static constexpr bool PERM = true, AFTER_DRAIN = false;
    bf16_t* O; int ldc;
    __device__ __forceinline__ void operator()(const f32x4 (&acc)[2][2][4][2], const Unit& u, int wr, int wc, int fr, int fq) const {
        const int row0 = u.pm * BM + wr * 64 + fr, col0 = u.pn * HALF + wc * 32 + 8 * fq;
#pragma unroll
        for (int ai = 0; ai < 2; ++ai)
#pragma unroll
            for (int m = 0; m < 4; ++m) {
                bf16_t* rowp = O + (size_t)(row0 + ai * HALF + m * 16) * ldc + col0;
                float h[8];
#pragma unroll
                for (int n = 0; n < 2; ++n)
#pragma unroll
                    for (int j = 0; j < 4; ++j) h[4 * n + j] = fast_silu(acc[ai][0][m][n][j]) * acc[ai][1][m][n][j];
                u32x4 w; w.x = cvt_pk_bf16(h[0], h[1]); w.y = cvt_pk_bf16(h[2], h[3]); w.z = cvt_pk_bf16(h[4], h[5]); w.w = cvt_pk_bf16(h[6], h[7]);
                *(u32x4*)rowp = w;
            }
    }
};
struct EpiResGate {
    static constexpr bool PERM = false, AFTER_DRAIN = false;
    const float* base; float* out; int ldc; const float* gate; int gate_bstride; float coef;
    __device__ __forceinline__ void operator()(const f32x4 (&acc)[2][2][4][2], const Unit& u, int wr, int wc, int fr, int fq) const {
        const int row0 = u.pm * BM + wr * 64 + fr, col0 = u.pn * BM + wc * 32 + 4 * fq;
        const float* gp = gate + (size_t)((u.pm * BM) / 4096) * gate_bstride + col0;
        f32x4 gv[2][2];
#pragma unroll
        for (int bj = 0; bj < 2; ++bj)
#pragma unroll
            for (int n = 0; n < 2; ++n) gv[bj][n] = *(const f32x4*)(gp + bj * HALF + n * 16) * coef;
#pragma unroll
        for (int ai = 0; ai < 2; ++ai)
#pragma unroll
            for (int m = 0; m < 4; ++m) {
                const size_t off = (size_t)(row0 + ai * HALF + m * 16) * ldc + col0;
#pragma unroll
                for (int bj = 0; bj < 2; ++bj)
#pragma unroll
                    for (int n = 0; n < 2; ++n) { const f32x4 bs = *(const f32x4*)(base + off + bj * HALF + n * 16); *(f32x4*)(out + off + bj * HALF + n * 16) = bs + gv[bj][n] * acc[ai][bj][m][n]; }
            }
    }
};
struct EpiM1 {
    static constexpr bool PERM = true, AFTER_DRAIN = false;
    bf16_t* qkv; bf16_t* xp; float* beta; float* gl; const float* a_log; const float* dt_bias;
    __device__ __forceinline__ void operator()(const f32x4 (&acc)[2][2][4][2], const Unit& u, int wr, int wc, int fr, int fq) const {
        const int row0 = u.pm * BM + wr * 64 + fr;
        if (u.pn < 14) {
            bf16_t* base; int ldc, colt;
            if (u.pn < 12) { base = qkv; ldc = 3072; colt = u.pn * BM; } else { base = xp; ldc = 512; colt = (u.pn - 12) * BM; }
            const int col0 = colt + wc * 32 + 8 * fq;
#pragma unroll
            for (int ai = 0; ai < 2; ++ai)
#pragma unroll
                for (int m = 0; m < 4; ++m) { bf16_t* rowp = base + (size_t)(row0 + ai * HALF + m * 16) * ldc + col0;
#pragma unroll
                    for (int bj = 0; bj < 2; ++bj) { const f32x4 v0 = acc[ai][bj][m][0], v1 = acc[ai][bj][m][1];
                        u32x4 w; w.x = cvt_pk_bf16(v0[0], v0[1]); w.y = cvt_pk_bf16(v0[2], v0[3]); w.z = cvt_pk_bf16(v1[0], v1[1]); w.w = cvt_pk_bf16(v1[2], v1[3]);
                        *(u32x4*)(rowp + bj * HALF) = w; } }
        } else if (wc == 0 && fq < 2) {
            float al[8], db[8];
#pragma unroll
            for (int h = 0; h < 8; ++h) { al[h] = -expf(a_log[h]); db[h] = dt_bias[h]; }
#pragma unroll
            for (int ai = 0; ai < 2; ++ai)
#pragma unroll
                for (int m = 0; m < 4; ++m) { const size_t r = (size_t)(row0 + ai * HALF + m * 16);
#pragma unroll
                    for (int n = 0; n < 2; ++n) { const f32x4 v = acc[ai][0][m][n]; f32x4 o;
                        if (fq == 0) {
#pragma unroll
                            for (int j = 0; j < 4; ++j) o[j] = 1.0f / (1.0f + expf(-v[j]));
                            *(f32x4*)(beta + r * 8 + 4 * n) = o;
                        } else {
#pragma unroll
                            for (int j = 0; j < 4; ++j) { const float xx = v[j] + db[4 * n + j]; const float sp = xx > 20.f ? xx : log1pf(expf(xx)); o[j] = al[4 * n + j] * sp; }
                            *(f32x4*)(gl + r * 8 + 4 * n) = o;
                        } } }
        }
    }
};
struct EpiSigmoid {
    static constexpr bool PERM = true, AFTER_DRAIN = false;
    bf16_t* O; int ldc;
    __device__ __forceinline__ void operator()(const f32x4 (&acc)[2][2][4][2], const Unit& u, int wr, int wc, int fr, int fq) const {
        const int row0 = u.pm * BM + wr * 64 + fr, col0 = u.pn * BM + wc * 32 + 8 * fq;
#pragma unroll
        for (int ai = 0; ai < 2; ++ai)
#pragma unroll
            for (int m = 0; m < 4; ++m) { bf16_t* rowp = O + (size_t)(row0 + ai * HALF + m * 16) * ldc + col0;
#pragma unroll
                for (int bj = 0; bj < 2; ++bj) { const f32x4 v0 = acc[ai][bj][m][0], v1 = acc[ai][bj][m][1];
                    u32x4 w; w.x = cvt_pk_bf16(fast_sigmoid(v0[0]), fast_sigmoid(v0[1])); w.y = cvt_pk_bf16(fast_sigmoid(v0[2]), fast_sigmoid(v0[3]));
                    w.z = cvt_pk_bf16(fast_sigmoid(v1[0]), fast_sigmoid(v1[1])); w.w = cvt_pk_bf16(fast_sigmoid(v1[2]), fast_sigmoid(v1[3]));
                    *(u32x4*)(rowp + bj * HALF) = w; } }
    }
};
template <int ACT> struct EpiMulBf16 {
    static constexpr bool PERM = true, AFTER_DRAIN = false;
    const bf16_t* F; int ldf; bf16_t* O; int ldc;
    __device__ __forceinline__ void operator()(const f32x4 (&acc)[2][2][4][2], const Unit& u, int wr, int wc, int fr, int fq) const {
        const int row0 = u.pm * BM + wr * 64 + fr, col0 = u.pn * BM + wc * 32 + 8 * fq;
#pragma unroll
        for (int ai = 0; ai < 2; ++ai)
#pragma unroll
            for (int m = 0; m < 4; ++m) { const size_t r = (size_t)(row0 + ai * HALF + m * 16);
#pragma unroll
                for (int bj = 0; bj < 2; ++bj) { const f32x4 v0 = acc[ai][bj][m][0], v1 = acc[ai][bj][m][1];
                    const u32x4 f = *(const u32x4*)(F + r * ldf + col0 + bj * HALF);
                    float a[8] = {v0[0], v0[1], v0[2], v0[3], v1[0], v1[1], v1[2], v1[3]};
                    if (ACT == 1) {
#pragma unroll
                        for (int j = 0; j < 8; ++j) a[j] = fast_silu(a[j]);
                    }
                    u32x4 w; w.x = cvt_pk_bf16(bflo(f.x) * a[0], bfhi(f.x) * a[1]); w.y = cvt_pk_bf16(bflo(f.y) * a[2], bfhi(f.y) * a[3]);
                    w.z = cvt_pk_bf16(bflo(f.z) * a[4], bfhi(f.z) * a[5]); w.w = cvt_pk_bf16(bflo(f.w) * a[6], bfhi(f.w) * a[7]);
                    *(u32x4*)(O + r * ldc + col0 + bj * HALF) = w; } }
    }
};
}

struct Frame {
    LAS unsigned char* lds;
    int tid, lane, wave, G, vcu;
    const float* in[20]; float* out; unsigned char* ws;
};

__device__ __forceinline__ void tr_item(const float* W, int ld_src, int k0, int c0, bf16* WT, int ld_dst, int r0, int dk0, LAS float* scr, int lane) {
#pragma unroll 8
    for (int i = 0; i < 32; ++i) { const int kk = 2 * i + (lane >> 5); scr[kk * 33 + (lane & 31)] = W[(size_t)(k0 + kk) * ld_src + c0 + (lane & 31)]; }
    LDS_WAIT(); asm volatile("" ::: "memory");
    const int c = lane & 7;
#pragma unroll
    for (int j = 0; j < 4; ++j) { const int n = (lane >> 3) + 8 * j; const LAS float* s = scr + (8 * c) * 33 + n;
        v4u o; o.x = pk2(s[0 * 33], s[1 * 33]); o.y = pk2(s[2 * 33], s[3 * 33]); o.z = pk2(s[4 * 33], s[5 * 33]); o.w = pk2(s[6 * 33], s[7 * 33]);
        *(GAS v4u*)(WT + (size_t)(r0 + n) * ld_dst + dk0 + k0 + 8 * c) = o; }
    LDS_WAIT(); asm volatile("" ::: "memory");
}

__device__ __forceinline__ void p0_prologue(Frame& F) {
    LAS float* scr = (LAS float*)(F.lds + RING_OFF + F.wave * 16384);
    const int gw = F.vcu * NWAVES + F.wave, NGW = F.G * NWAVES;
    unsigned char* ws = F.ws;
    constexpr int I_FIN = (D / 64) * (NFF_IN / 32);
    constexpr int I_FOUT = (FF / 64) * (D / 32);
    constexpr int I_QKV = (D / 64) * (3072 / 32);
    constexpr int I_XP = (D / 64) * (512 / 32);
    constexpr int I_Z = (D / 64) * (1024 / 32);
    constexpr int I_G = (D / 64) * (2048 / 32);
    constexpr int I_SQ = (D / 64) * (D / 32);
    constexpr int NITEMS = 2 * I_FIN + 2 * I_FOUT + I_QKV + I_XP + I_Z + I_G + 3 * I_SQ;
    for (int it = gw; it < NITEMS; it += NGW) {
        int r = it;
        if (r < 2 * I_FIN) { const int which = r / I_FIN; r -= which * I_FIN; const int kb = r / 176, cb = r % 176;
            const int half = cb / 88, c2 = cb % 88, p = c2 / 4, w = c2 % 4;
            tr_item((which ? F.in[7] : F.in[5]), NFF_IN, 64 * kb, 32 * cb, (bf16*)(ws + (which ? WS_W2IN : WS_W1IN)), D, 256 * p + 128 * half + 32 * w, 0, scr, F.lane); continue; }
        r -= 2 * I_FIN;
        if (r < 2 * I_FOUT) { const int which = r / I_FOUT; r -= which * I_FOUT; const int kb = r / 32, cb = r % 32;
            tr_item((which ? F.in[8] : F.in[6]), D, 64 * kb, 32 * cb, (bf16*)(ws + (which ? WS_W2OUT : WS_W1OUT)), FF, 32 * cb, 0, scr, F.lane); continue; }
        r -= 2 * I_FOUT;
        if (r < I_QKV) { const int kb = r / 96, cb = r % 96; tr_item(F.in[9], MIXW, 64 * kb, 512 + 32 * cb, (bf16*)(ws + WS_WM1), D, 32 * cb, 0, scr, F.lane); continue; }
        r -= I_QKV;
        if (r < I_XP) { const int kb = r / 16, cb = r % 16; tr_item(F.in[9], MIXW, 64 * kb, 32 * cb, (bf16*)(ws + WS_WM1), D, 3072 + 32 * cb, 0, scr, F.lane); continue; }
        r -= I_XP;
        if (r < I_Z) { const int kb = r / 32, cb = r % 32; tr_item(F.in[9], MIXW, 64 * kb, 3584 + 32 * cb, (bf16*)(ws + WS_WZ), D, 32 * cb, 0, scr, F.lane); continue; }
        r -= I_Z;
        if (r < I_G) { const int kb = r / 64, cb = r % 64; tr_item(F.in[9], MIXW, 64 * kb, 4624 + 32 * cb, (bf16*)(ws + WS_WG), D, 32 * cb, 0, scr, F.lane); continue; }
        r -= I_G;
        { const int which = r / I_SQ; r -= which * I_SQ; const int kb = r / 32, cb = r % 32;
          if (which == 0) tr_item(F.in[17], D, 64 * kb, 32 * cb, (bf16*)(ws + WS_WDN), D, 32 * cb, 0, scr, F.lane);
          else tr_item(F.in[18], D, 64 * kb, 32 * cb, (bf16*)(ws + WS_WMO2), 2 * D, 32 * cb, (which - 1) * D, scr, F.lane); }
    }
    {
        bf16* wm1 = (bf16*)(ws + WS_WM1);
        for (int it = gw; it < 16 * 16; it += NGW) { const int n = it & 15, k = (it >> 4) * 64 + F.lane; wm1[(size_t)(3584 + n) * D + k] = (bf16)f2bf(F.in[9][(size_t)k * MIXW + 4608 + n]); }
        for (int it = gw; it < 240 * D / 8 / 64; it += NGW) *(GAS v4u*)(wm1 + (size_t)3600 * D + ((size_t)it * 64 + F.lane) * 8) = (v4u){0u, 0u, 0u, 0u};
    }
    {
        const float* pw = F.in[14]; const float* ps = F.in[15]; const float* pp = F.in[16];
        float* wpp32 = (float*)(ws + WS_WPP32);
        for (int it = gw; it < 512 * 16; it += NGW) {
            const int k = it >> 4, g = k >> 7, n = (it & 15) * 64 + F.lane;
            float a = 0.f;
#pragma unroll 8
            for (int d = 0; d < 128; ++d) a += (pw[(size_t)k * 128 + d] * ps[g * 128 + d]) * pp[(size_t)(g * 128 + d) * D + n];
            wpp32[(size_t)k * D + n] = a;
        }
    }
    {
        __syncthreads();
        LAS float* sc = (LAS float*)(F.lds + 65536);
        LAS float* red = (LAS float*)(F.lds);
        for (int e = F.tid; e < 4 * D; e += NWAVES * 64) { const float cv = F.in[1][e]; sc[e] = cv / (1.0f + expf(-cv)); }
        __syncthreads();
        const float* aw = F.in[2]; const float* ab = F.in[3]; float* mod = (float*)(ws + WS_MOD);
        for (int it = F.vcu; it < NMOD / 64; it += F.G) {
            const int n = it * 64 + F.lane; float a0 = 0.f, a1 = 0.f, a2 = 0.f, a3 = 0.f;
#pragma unroll 16
            for (int kk = 0; kk < 128; ++kk) { const int k = F.wave * 128 + kk; const float w = aw[(size_t)k * NMOD + n];
                a0 += sc[k] * w; a1 += sc[D + k] * w; a2 += sc[2 * D + k] * w; a3 += sc[3 * D + k] * w; }
            red[(F.wave * 4 + 0) * 64 + F.lane] = a0; red[(F.wave * 4 + 1) * 64 + F.lane] = a1; red[(F.wave * 4 + 2) * 64 + F.lane] = a2; red[(F.wave * 4 + 3) * 64 + F.lane] = a3;
            __syncthreads();
            if (F.tid < 256) { const int b = F.tid >> 6, l = F.tid & 63; float s = ab[it * 64 + l];
#pragma unroll
                for (int w = 0; w < 8; ++w) s += red[(w * 4 + b) * 64 + l];
                mod[(size_t)b * NMOD + it * 64 + l] = s; }
            __syncthreads();
        }
    }
}

__device__ __forceinline__ void normmod_rows(Frame& F, const float* X, bf16* H, const float* g, int sub) {
    const int gw = F.vcu * NWAVES + F.wave, NGW = F.G * NWAVES;
    const float* mod = (const float*)(F.ws + WS_MOD);
    for (int m = gw; m < M; m += NGW) {
        const GAS f32x4* xr = (const GAS f32x4*)(X + (size_t)m * D) + F.lane;
        f32x4 v[4]; float s = 0.f;
#pragma unroll
        for (int j = 0; j < 4; ++j) { v[j] = xr[64 * j]; s += (v[j].x * v[j].x + v[j].y * v[j].y) + (v[j].z * v[j].z + v[j].w * v[j].w); }
        const float rs = 1.0f / sqrtf(wave_sum(s) * (1.f / D) + RMS_EPS);
        const float* mb = mod + (size_t)(m / T) * NMOD + sub * 3 * D;
        GAS v2u* o8 = (GAS v2u*)(H + (size_t)m * D) + F.lane;
#pragma unroll
        for (int j = 0; j < 4; ++j) { const int col = 4 * (64 * j + F.lane);
            const f32x4 gg = *(const f32x4*)(g + col), sh = *(const f32x4*)(mb + col), sc = *(const f32x4*)(mb + D + col);
            const f32x4 o = (v[j] * rs * gg) * (sc + 1.0f) + sh;
            v2u w; w.x = pk2(o.x, o.y); w.y = pk2(o.z, o.w); o8[64 * j] = w; }
    }
}
__device__ __forceinline__ void final_norm_rows(Frame& F, const float* X, float* O, const float* g) {
    const int gw = F.vcu * NWAVES + F.wave, NGW = F.G * NWAVES;
    for (int m = gw; m < M; m += NGW) {
        const GAS f32x4* xr = (const GAS f32x4*)(X + (size_t)m * D) + F.lane;
        f32x4 v[4]; float s = 0.f;
#pragma unroll
        for (int j = 0; j < 4; ++j) { v[j] = xr[64 * j]; s += (v[j].x * v[j].x + v[j].y * v[j].y) + (v[j].z * v[j].z + v[j].w * v[j].w); }
        const float rs = 1.0f / sqrtf(wave_sum(s) * (1.f / D) + RMS_EPS);
        GAS f32x4* orow = (GAS f32x4*)(O + (size_t)m * D) + F.lane;
#pragma unroll
        for (int j = 0; j < 4; ++j) { const f32x4 gg = *(const f32x4*)(g + 4 * (64 * j + F.lane)); orow[64 * j] = v[j] * rs * gg; }
    }
}
__device__ __forceinline__ void pool_phase(Frame& F) {
    const bf16* xp = (const bf16*)(F.ws + WS_XP); bf16* pooled = (bf16*)(F.ws + WS_POOLED);
    const int gw = F.vcu * NWAVES + F.wave, NGW = F.G * NWAVES;
    const int c0 = F.lane * 8, w = 2 << (F.lane >> 4);
    for (int ch = gw; ch < M / 64; ch += NGW) {
        const int row0 = ch * 64, t0 = row0 % T;
        float sum[8] = {0.f, 0.f, 0.f, 0.f, 0.f, 0.f, 0.f, 0.f};
        for (int s = 15; s >= 1; --s) {
            if (s <= w - 1 && t0 - s >= 0) { const v4u x = *(const GAS v4u*)(xp + (size_t)(row0 - s) * POOLW + c0);
                sum[0] += bflo(x.x); sum[1] += bfhi(x.x); sum[2] += bflo(x.y); sum[3] += bfhi(x.y); sum[4] += bflo(x.z); sum[5] += bfhi(x.z); sum[6] += bflo(x.w); sum[7] += bfhi(x.w); }
        }
        for (int i = 0; i < 64; ++i) {
            const int t = t0 + i; const v4u x = *(const GAS v4u*)(xp + (size_t)(row0 + i) * POOLW + c0);
            float xv[8] = {bflo(x.x), bfhi(x.x), bflo(x.y), bfhi(x.y), bflo(x.z), bfhi(x.z), bflo(x.w), bfhi(x.w)};
            const float inv = 1.0f / (float)((t + 1) < w ? (t + 1) : w);
            float o[8];
#pragma unroll
            for (int j = 0; j < 8; ++j) { sum[j] += xv[j]; o[j] = sum[j] * inv - xv[j]; }
            v4u ov; ov.x = pk2(o[0], o[1]); ov.y = pk2(o[2], o[3]); ov.z = pk2(o[4], o[5]); ov.w = pk2(o[6], o[7]);
            *(GAS v4u*)(pooled + (size_t)(row0 + i) * POOLW + c0) = ov;
            if (t - w + 1 >= 0) { const v4u y = *(const GAS v4u*)(xp + (size_t)(row0 + i - w + 1) * POOLW + c0);
                sum[0] -= bflo(y.x); sum[1] -= bfhi(y.x); sum[2] -= bflo(y.y); sum[3] -= bfhi(y.y); sum[4] -= bflo(y.z); sum[5] -= bfhi(y.z); sum[6] -= bflo(y.w); sum[7] -= bfhi(y.w); }
        }
    }
}

__global__ void __launch_bounds__(128) dn_naive(const bf16* __restrict__ qkv, const float* __restrict__ conv_w, const float* __restrict__ beta, const float* __restrict__ gl,
                                                const float* __restrict__ dn_g, bf16* __restrict__ onorm) {
    __shared__ float qs[128], ks[128], red[8];
    const int bh = blockIdx.x, b = bh >> 3, h = bh & 7, c = threadIdx.x, wv = c >> 6;
    float S[128];
#pragma unroll
    for (int k = 0; k < 128; ++k) S[k] = 0.f;
    float wq[4], wk[4], wvv[4];
#pragma unroll
    for (int j = 0; j < 4; ++j) { wq[j] = conv_w[j * 3072 + h * 128 + c]; wk[j] = conv_w[j * 3072 + 1024 + h * 128 + c]; wvv[j] = conv_w[j * 3072 + 2048 + h * 128 + c]; }
    float hq0 = 0.f, hq1 = 0.f, hq2 = 0.f, hk0 = 0.f, hk1 = 0.f, hk2 = 0.f, hv0 = 0.f, hv1 = 0.f, hv2 = 0.f;
    const float dg = dn_g[c];
    for (int t = 0; t < T; ++t) {
        const size_t row = (size_t)b * T + t;
        const float xq = bf2f(qkv[row * 3072 + h * 128 + c]), xk = bf2f(qkv[row * 3072 + 1024 + h * 128 + c]), xv = bf2f(qkv[row * 3072 + 2048 + h * 128 + c]);
        float yq = wq[0] * hq0 + wq[1] * hq1 + wq[2] * hq2 + wq[3] * xq;
        float yk = wk[0] * hk0 + wk[1] * hk1 + wk[2] * hk2 + wk[3] * xk;
        float yv = wvv[0] * hv0 + wvv[1] * hv1 + wvv[2] * hv2 + wvv[3] * xv;
        hq0 = hq1; hq1 = hq2; hq2 = xq; hk0 = hk1; hk1 = hk2; hk2 = xk; hv0 = hv1; hv1 = hv2; hv2 = xv;
        yq = yq / (1.0f + expf(-yq)); yk = yk / (1.0f + expf(-yk)); yv = yv / (1.0f + expf(-yv));
        float sq = yq * yq, sk = yk * yk;
#pragma unroll
        for (int o = 1; o < 64; o <<= 1) { sq += __shfl_xor(sq, o); sk += __shfl_xor(sk, o); }
        if ((c & 63) == 0) { red[wv * 2] = sq; red[wv * 2 + 1] = sk; }
        __syncthreads();
        const float tq = red[0] + red[2], tk = red[1] + red[3];
        const float qh = yq * (1.0f / sqrtf(tq + L2_EPS)) * 0.08838834764831845f, kh = yk * (1.0f / sqrtf(tk + L2_EPS));
        qs[c] = qh; ks[c] = kh;
        __syncthreads();
        const float bt = beta[row * 8 + h], a = expf(gl[row * 8 + h]);
        float kS = 0.f;
#pragma unroll
        for (int k = 0; k < 128; ++k) kS += ks[k] * S[k];
        const float coef = bt * (yv - a * kS);
        float o = 0.f;
#pragma unroll
        for (int k = 0; k < 128; ++k) { S[k] = a * S[k] + ks[k] * coef; o += qs[k] * S[k]; }
        float so = o * o;
#pragma unroll
        for (int of = 1; of < 64; of <<= 1) so += __shfl_xor(so, of);
        if ((c & 63) == 0) red[4 + wv] = so;
        __syncthreads();
        const float to = red[4] + red[5];
        const float on = o * (1.0f / sqrtf(to * (1.0f / 128.0f) + RMS_EPS)) * dg;
        onorm[row * 1024 + h * 128 + c] = (bf16)f2bf(on);
        __syncthreads();
    }
}

struct Args { const float* in[20]; float* out; unsigned char* ws; int ph_lo, ph_hi; };
constexpr int N_PHASES = 17;
__global__ void __launch_bounds__(NWAVES * 64, 2) mk_fwd(Args args) {
    extern __shared__ __attribute__((aligned(16))) unsigned char lds[];
    Frame F;
    F.lds = (LAS unsigned char*)lds;
    F.tid = threadIdx.x; F.lane = F.tid & 63; F.wave = __builtin_amdgcn_readfirstlane(F.tid >> 6);
    F.G = gridDim.x; { const int bx = blockIdx.x; F.vcu = (F.G % 8 == 0) ? (bx % 8) * (F.G / 8) + bx / 8 : bx; }
#pragma unroll
    for (int i = 0; i < 20; ++i) F.in[i] = args.in[i];
    F.out = args.out; F.ws = args.ws;
    unsigned char* ws = args.ws;
    const int lo = args.ph_lo, hi = args.ph_hi;
#define IN(k) (lo <= (k) && (k) < hi)
    bf16* Hb = (bf16*)(ws + WS_H);
    const float* mod = (const float*)(ws + WS_MOD);

    if (IN(0)) p0_prologue(F);
    if (IN(1)) {
        LAS float* scr = (LAS float*)(F.lds + RING_OFF + F.wave * 16384);
        const int gw = F.vcu * NWAVES + F.wave, NGW = F.G * NWAVES;
        for (int it = gw; it < (512 / 64) * (D / 32); it += NGW) { const int kb = it / 32, cb = it % 32; tr_item((const float*)(ws + WS_WPP32), D, 64 * kb, 32 * cb, (bf16*)(ws + WS_WPP), 512, 32 * cb, 0, scr, F.lane); }
        normmod_rows(F, F.in[0], Hb, F.in[4] + 0 * D, 0);
    }
    if (IN(2)) { pg8::Gemm g{Hb, (const bf16*)(ws + WS_W1IN), M, NFF_IN, D}; pg8::StaticOrder S; S.init(M, NFF_IN, F.G, (int)blockIdx.x);
        pg8::EpiSwiglu E{(bf16*)(ws + WS_HID), FF};
        pg8::gemm_phase<pg8::EpiSwiglu, pg8::StaticOrder, PG8_ALIGN, PG8_SP2>(F.lds + RING_OFF, g, S, E); }
    if (IN(3)) { pg8::Gemm g{(const bf16*)(ws + WS_HID), (const bf16*)(ws + WS_W1OUT), M, D, FF}; pg8::StaticOrder S; S.init(M, D, F.G, (int)blockIdx.x);
        pg8::EpiResGate E{F.in[0], F.out, D, mod + 0 * 3 * D + 2 * D, NMOD, 0.5f};
        pg8::gemm_phase<pg8::EpiResGate, pg8::StaticOrder, PG8_ALIGN, PG8_SP2>(F.lds + RING_OFF, g, S, E); }
    if (IN(4)) normmod_rows(F, F.out, Hb, F.in[4] + 1 * D, 1);
    if (IN(5)) { pg8::Gemm g{Hb, (const bf16*)(ws + WS_WM1), M, NM1, D}; pg8::StaticOrder S; S.init(M, NM1, F.G, (int)blockIdx.x);
        pg8::EpiM1 E{(bf16*)(ws + WS_QKV), (bf16*)(ws + WS_XP), (float*)(ws + WS_BETA), (float*)(ws + WS_GL), F.in[11], F.in[12]};
        pg8::gemm_phase<pg8::EpiM1, pg8::StaticOrder, PG8_ALIGN, PG8_SP2>(F.lds + RING_OFF, g, S, E); }
    if (IN(6)) pool_phase(F);
    if (IN(8)) { pg8::Gemm g{Hb, (const bf16*)(ws + WS_WG), M, 2048, D}; pg8::StaticOrder S; S.init(M, 2048, F.G, (int)blockIdx.x);
        pg8::EpiSigmoid E{(bf16*)(ws + WS_GATES), 2048};
        pg8::gemm_phase<pg8::EpiSigmoid, pg8::StaticOrder, PG8_ALIGN, PG8_SP2>(F.lds + RING_OFF, g, S, E); }
    if (IN(9)) { pg8::Gemm g{Hb, (const bf16*)(ws + WS_WZ), M, D, D}; pg8::StaticOrder S; S.init(M, D, F.G, (int)blockIdx.x);
        pg8::EpiMulBf16<1> E{(const bf16*)(ws + WS_ONORM), D, (bf16*)(ws + WS_OG), D};
        pg8::gemm_phase<pg8::EpiMulBf16<1>, pg8::StaticOrder, PG8_ALIGN, PG8_SP2>(F.lds + RING_OFF, g, S, E); }
    if (IN(10)) { pg8::Gemm g{(const bf16*)(ws + WS_POOLED), (const bf16*)(ws + WS_WPP), M, D, POOLW}; pg8::StaticOrder S; S.init(M, D, F.G, (int)blockIdx.x);
        pg8::EpiMulBf16<0> E{(const bf16*)(ws + WS_GATES), 2048, (bf16*)(ws + WS_TAB), 2048};
        pg8::gemm_phase<pg8::EpiMulBf16<0>, pg8::StaticOrder, PG8_ALIGN, PG8_SP2>(F.lds + RING_OFF, g, S, E); }
    if (IN(11)) { pg8::Gemm g{(const bf16*)(ws + WS_OG), (const bf16*)(ws + WS_WDN), M, D, D}; pg8::StaticOrder S; S.init(M, D, F.G, (int)blockIdx.x);
        pg8::EpiMulBf16<0> E{(const bf16*)(ws + WS_GATES) + 1024, 2048, (bf16*)(ws + WS_TAB) + 1024, 2048};
        pg8::gemm_phase<pg8::EpiMulBf16<0>, pg8::StaticOrder, PG8_ALIGN, PG8_SP2>(F.lds + RING_OFF, g, S, E); }
    if (IN(12)) { pg8::Gemm g{(const bf16*)(ws + WS_TAB), (const bf16*)(ws + WS_WMO2), M, D, 2 * D}; pg8::StaticOrder S; S.init(M, D, F.G, (int)blockIdx.x);
        pg8::EpiResGate E{F.out, F.out, D, mod + 1 * 3 * D + 2 * D, NMOD, 1.0f};
        pg8::gemm_phase<pg8::EpiResGate, pg8::StaticOrder, PG8_ALIGN, PG8_SP2>(F.lds + RING_OFF, g, S, E); }
    if (IN(13)) normmod_rows(F, F.out, Hb, F.in[4] + 2 * D, 2);
    if (IN(14)) { pg8::Gemm g{Hb, (const bf16*)(ws + WS_W2IN), M, NFF_IN, D}; pg8::StaticOrder S; S.init(M, NFF_IN, F.G, (int)blockIdx.x);
        pg8::EpiSwiglu E{(bf16*)(ws + WS_HID), FF};
        pg8::gemm_phase<pg8::EpiSwiglu, pg8::StaticOrder, PG8_ALIGN, PG8_SP2>(F.lds + RING_OFF, g, S, E); }
    if (IN(15)) { pg8::Gemm g{(const bf16*)(ws + WS_HID), (const bf16*)(ws + WS_W2OUT), M, D, FF}; pg8::StaticOrder S; S.init(M, D, F.G, (int)blockIdx.x);
        pg8::EpiResGate E{F.out, F.out, D, mod + 2 * 3 * D + 2 * D, NMOD, 0.5f};
        pg8::gemm_phase<pg8::EpiResGate, pg8::StaticOrder, PG8_ALIGN, PG8_SP2>(F.lds + RING_OFF, g, S, E); }
    if (IN(16)) final_norm_rows(F, F.out, F.out, F.in[19]);
#undef IN
}

extern "C" void kernel_launch(void* const* d_in, const int* in_sizes, int n_in, void* d_out, int out_size, void* d_ws, size_t ws_size, hipStream_t stream) {
    static int grid = 0;
    if (grid == 0) {
        if (n_in != 20 || in_sizes[0] != M * D || out_size != M * D || ws_size < WS_END) { fprintf(stderr, "kernel_launch: unexpected shapes (n_in %d, in0 %d, out %d, ws %zu)\n", n_in, n_in > 0 ? in_sizes[0] : -1, out_size, ws_size); grid = -1; return; }
        int dev = 0, cus = 0;
        if (hipGetDevice(&dev) != hipSuccess || hipDeviceGetAttribute(&cus, hipDeviceAttributeMultiprocessorCount, dev) != hipSuccess) { grid = -1; return; }
        if (hipFuncSetAttribute((const void*)mk_fwd, hipFuncAttributeMaxDynamicSharedMemorySize, LDS_BYTES) != hipSuccess) { fprintf(stderr, "kernel_launch: hipFuncSetAttribute failed\n"); grid = -1; return; }
        (void)hipGetLastError();
        grid = cus;
    }
    if (grid < 0) return;
    Args a{};
    for (int i = 0; i < 20; ++i) a.in[i] = (const float*)d_in[i];
    a.out = (float*)d_out; a.ws = (unsigned char*)d_ws;
    for (int ph = 0; ph < N_PHASES; ++ph) {
        if (ph == 7) {
            hipLaunchKernelGGL(dn_naive, dim3(32), dim3(128), 0, stream, (const bf16*)((unsigned char*)d_ws + WS_QKV), (const float*)d_in[10], (const float*)((unsigned char*)d_ws + WS_BETA),
                               (const float*)((unsigned char*)d_ws + WS_GL), (const float*)d_in[13], (bf16*)((unsigned char*)d_ws + WS_ONORM));
            continue;
        }
        a.ph_lo = ph; a.ph_hi = ph + 1;
        hipLaunchKernelGGL(mk_fwd, dim3(grid), dim3(NWAVES * 64), LDS_BYTES, stream, a);
    }
}
```

```cpp
#include <hip/hip_runtime.h>
#include <cstdio>
#include <cstdint>
namespace pg8 {
#define PG8_LAS __attribute__((address_space(3)))
typedef unsigned short bf16_t;
typedef short bf16x8 __attribute__((ext_vector_type(8)));
typedef float f32x4 __attribute__((ext_vector_type(4)));
typedef unsigned u32x4 __attribute__((ext_vector_type(4)));
constexpr int BM = 256, BK = 64, HALF = 128, HTB = HALF * BK * 2  , STAGE_BYTES = 8 * HTB, NXCD = 8, WGM = 8;

__host__ __device__ __forceinline__ int lds_byte(int r, int c) { const int st = (r >> 4) * 2 + (c >> 5), rr = r & 15, cc = c & 31, ob = rr * 64 + cc * 2; return st * 1024 + (ob ^ (((ob >> 9) & 1) << 5)); }
__host__ __device__ __forceinline__ void stage_rc(int b, int& R, int& C) { const int st = b / 1024, sb = b % 1024, swz = sb ^ (((sb >> 9) & 1) << 5); R = (st >> 1) * 16 + swz / 64; C = (st & 1) * 32 + (swz % 64) / 2; }
__host__ __device__ __forceinline__ int perm32(int rho) { const int n = rho >> 4, i = rho & 15; return 8 * (i >> 2) + 4 * n + (i & 3); }

struct Unit { int pm, pn; };
struct Gemm { const bf16_t* A; const bf16_t* Bt; int M, N, K; };

struct StaticOrder {
    int nM, nN, nwg, G, c;
    __host__ __device__ void init(int M, int N, int G_, int c_) { nM = M / BM; nN = N / BM; nwg = nM * nN; G = G_; c = c_; }
    __host__ __device__ bool next(int i, Unit& u) const {
        const long L = (long)i * G + c; if (L >= nwg) return false;
        int wgid = (int)L; { const int q = nwg / NXCD, r = nwg % NXCD, xcd = wgid % NXCD, off = wgid / NXCD; wgid = (xcd < r ? xcd * (q + 1) : r * (q + 1) + (xcd - r) * q) + off; }
        const int nig = WGM * nN, gid = wgid / nig, fm = gid * WGM, gsz = (nM - fm) < WGM ? (nM - fm) : WGM;
        u.pm = fm + ((wgid % nig) % gsz); u.pn = (wgid % nig) / gsz; return true;
    }
    __device__ __forceinline__ void a_ready(const Unit&) const {}
    __device__ __forceinline__ void done(const Unit&) const {}
};

typedef float f32x2_t __attribute__((ext_vector_type(2))); typedef __bf16 bf16x2_t __attribute__((ext_vector_type(2)));
__device__ __forceinline__ unsigned cvt_pk_bf16(float lo, float hi) { f32x2_t v = {lo, hi}; bf16x2_t b = __builtin_convertvector(v, bf16x2_t); return __builtin_bit_cast(unsigned, b); }
typedef float f32x2 __attribute__((ext_vector_type(2)));
__device__ __forceinline__ f32x2 gelu_pk(f32x2 v) {
    const f32x2 av = __builtin_elementwise_abs(v), d = av * 0.2316418882f + 1.0f;
    f32x2 t; t.x = __builtin_amdgcn_rcpf(d.x); t.y = __builtin_amdgcn_rcpf(d.y);
    f32x2 q = t * 0.5307027145f + (-0.7265760135f); q = q * t + 0.7107068705f; q = q * t + (-0.142248368f); q = q * t + 0.127414796f; q = q * t;
    const f32x2 s = (v * v) * (-0.72134752044f);
    f32x2 e; e.x = __builtin_amdgcn_exp2f(s.x); e.y = __builtin_amdgcn_exp2f(s.y);
    const f32x2 m = v * (q * e), r = v - m;
    f32x2 o; o.x = v.x < 0.f ? m.x : r.x; o.y = v.y < 0.f ? m.y : r.y; return o;
}

template <int ACT  > struct EpiBf16 {
    static constexpr bool PERM = true, AFTER_DRAIN = false; static_assert(ACT == 0 || ACT == 1, "EpiBf16: ACT is 0 (none) or 1 (gelu_pk)");
    bf16_t* O; int ldc; const float* bias; int split_cols; size_t split_stride; float scale0;
    __device__ __forceinline__ void operator()(const f32x4 (&acc)[2][2][4][2], const Unit& u, int wr, int wc, int fr, int fq) const {
        const int row0 = u.pm * BM + wr * 64 + fr; int colt = u.pn * BM; bf16_t* base = O;
        float sc = 1.f; if (split_cols) { const int t = colt / split_cols; base += (size_t)t * split_stride; colt -= t * split_cols; if (t == 0) sc = scale0; }
        const int col0 = colt + wc * 32 + 8 * fq, bcol0 = u.pn * BM + wc * 32 + 8 * fq;
        f32x4 bv[2][2];
#pragma unroll
        for (int bj = 0; bj < 2; ++bj)
#pragma unroll
            for (int n = 0; n < 2; ++n) bv[bj][n] = bias ? *(const f32x4*)(bias + bcol0 + bj * HALF + 4 * n) : (f32x4){0.f, 0.f, 0.f, 0.f};
#pragma unroll
        for (int ai = 0; ai < 2; ++ai)
#pragma unroll
            for (int m = 0; m < 4; ++m) { bf16_t* rowp = base + (size_t)(row0 + ai * HALF + m * 16) * ldc + col0;
#pragma unroll
                for (int bj = 0; bj < 2; ++bj) { f32x4 v0 = acc[ai][bj][m][0] + bv[bj][0], v1 = acc[ai][bj][m][1] + bv[bj][1];
                    if (ACT == 1) { f32x2 a = gelu_pk((f32x2){v0[0], v0[1]}), b = gelu_pk((f32x2){v0[2], v0[3]}), c = gelu_pk((f32x2){v1[0], v1[1]}), d = gelu_pk((f32x2){v1[2], v1[3]});
                        v0 = (f32x4){a.x, a.y, b.x, b.y}; v1 = (f32x4){c.x, c.y, d.x, d.y}; }
                    v0 = v0 * sc; v1 = v1 * sc; u32x4 w; w.x = cvt_pk_bf16(v0[0], v0[1]); w.y = cvt_pk_bf16(v0[2], v0[3]); w.z = cvt_pk_bf16(v1[0], v1[1]); w.w = cvt_pk_bf16(v1[2], v1[3]);
                    *(u32x4*)(rowp + bj * HALF) = w; } }
    }
};

struct PanelStats {
    unsigned* xbuf;
    unsigned* cnt;
    unsigned* tmo;
    int ntn; float eps;
    unsigned code;
    __device__ __forceinline__ bool run(const f32x4 (&v)[2][2][4][2], const Unit& u, int wr, int wc, int fr, int fq, PG8_LAS unsigned char* lds, int wid, int lane) const {
        typedef float f32x2v __attribute__((ext_vector_type(2)));
        PG8_LAS f32x2v* P = (PG8_LAS f32x2v*)lds;
        PG8_LAS f32x2v* S = (PG8_LAS f32x2v*)(lds + 8192);
        PG8_LAS unsigned* flag = (PG8_LAS unsigned*)(lds + 8192 + 2048);
#pragma unroll
        for (int ai = 0; ai < 2; ++ai)
#pragma unroll
            for (int m = 0; m < 4; ++m) {
                float s = 0.f;
#pragma unroll
                for (int bj = 0; bj < 2; ++bj)
#pragma unroll
                    for (int n = 0; n < 2; ++n) { const f32x4 x = v[ai][bj][m][n]; s += (x[0] + x[1]) + (x[2] + x[3]); }
                s += __shfl_xor(s, 16); s += __shfl_xor(s, 32);
                const float mw = s * (1.0f / 64.0f); float q = 0.f;
#pragma unroll
                for (int bj = 0; bj < 2; ++bj)
#pragma unroll
                    for (int n = 0; n < 2; ++n) { const f32x4 d = v[ai][bj][m][n] - mw; q += (d[0] * d[0] + d[1] * d[1]) + (d[2] * d[2] + d[3] * d[3]); }
                q += __shfl_xor(q, 16); q += __shfl_xor(q, 32);
                if (fq == 0) P[(ai * HALF + wr * 64 + m * 16 + fr) * 4 + wc] = (f32x2v){mw, q};
            }
        asm volatile("s_waitcnt lgkmcnt(0)" ::: "memory"); __builtin_amdgcn_s_barrier(); asm volatile("" ::: "memory");
#if defined(BROKEN_EXCHANGE_NO_WAIT)
#warning BROKEN CONTROL BUILD: the row-statistics exchange does not wait; results are wrong by design
        if (blockIdx.x >= 64) { const long long t0_ = clock64(); while (clock64() - t0_ < 60000) __builtin_amdgcn_s_sleep(8); }
#endif
        const int row = wid * 32 + (lane & 31);
        if (lane < 32) {
            const f32x2v a = P[row * 4 + 0], b = P[row * 4 + 1], c = P[row * 4 + 2], d = P[row * 4 + 3];
            const float mt = (a.x + b.x + c.x + d.x) * 0.25f;
            const float da = a.x - mt, db = b.x - mt, dc = c.x - mt, dd = d.x - mt;
            const float m2 = (a.y + b.y) + (c.y + d.y) + 64.0f * ((da * da + db * db) + (dc * dc + dd * dd));
            unsigned long long* slot = (unsigned long long*)xbuf + ((size_t)(u.pm * BM + row) * 4 + u.pn);
            __hip_atomic_store(slot, ((unsigned long long)__float_as_uint(m2) << 32) | __float_as_uint(mt), __ATOMIC_RELAXED, __HIP_MEMORY_SCOPE_AGENT);
        }
        asm volatile("s_waitcnt vmcnt(0)" ::: "memory");
        if (lane == 0) __hip_atomic_fetch_add(cnt + 64 * u.pm, 1u, __ATOMIC_RELAXED, __HIP_MEMORY_SCOPE_AGENT);
        if (wid == 0) {
            bool dead = false; const unsigned long long t0 = __builtin_amdgcn_s_memrealtime(); const unsigned want = 8u * (unsigned)ntn;
            for (;;) {
#if defined(BROKEN_EXCHANGE_NO_WAIT)
                break;
#endif
                if ((unsigned)__builtin_amdgcn_readfirstlane(__hip_atomic_load(cnt + 64 * u.pm, __ATOMIC_RELAXED, __HIP_MEMORY_SCOPE_AGENT)) >= want) break;
                if (__builtin_amdgcn_s_memrealtime() - t0 > 2000000ull) {
                    if (lane == 0) { unsigned expect = 0u; __hip_atomic_compare_exchange_strong(tmo + 1, &expect, code | (unsigned)(u.pm & 0xff), __ATOMIC_RELAXED, __ATOMIC_RELAXED, __HIP_MEMORY_SCOPE_AGENT);
                                     __hip_atomic_store(tmo, 1u, __ATOMIC_RELAXED, __HIP_MEMORY_SCOPE_AGENT); }
                    dead = true; break; }
                __builtin_amdgcn_s_sleep(2);
            }
            __builtin_amdgcn_fence(__ATOMIC_ACQUIRE, "agent");
            if (lane == 0) flag[0] = dead ? 1u : 0u;
        }
        asm volatile("s_waitcnt vmcnt(0) lgkmcnt(0)" ::: "memory"); __builtin_amdgcn_s_barrier(); asm volatile("" ::: "memory");
        const bool bad = flag[0] != 0u;
        if (lane < 32) {
            const unsigned long long* slot = (const unsigned long long*)xbuf + (size_t)(u.pm * BM + row) * 4; float mt[4], m2[4]; float ms = 0.f;
#pragma unroll
            for (int t = 0; t < 4; ++t) { if (t < ntn) { const unsigned long long w = __hip_atomic_load(slot + t, __ATOMIC_RELAXED, __HIP_MEMORY_SCOPE_AGENT); mt[t] = __uint_as_float((unsigned)w); m2[t] = __uint_as_float((unsigned)(w >> 32)); } else { mt[t] = 0.f; m2[t] = 0.f; } ms += mt[t]; }
            const float mean = ms / (float)ntn; float q = 0.f;
#pragma unroll
            for (int t = 0; t < 4; ++t) if (t < ntn) { const float dm = mt[t] - mean; q += m2[t] + 256.0f * dm * dm; }
            S[row] = (f32x2v){mean, 1.0f / sqrtf(q / (256.0f * (float)ntn) + eps)};
        }
        asm volatile("s_waitcnt lgkmcnt(0)" ::: "memory"); __builtin_amdgcn_s_barrier(); asm volatile("" ::: "memory");
        return bad;
    }
};
struct EpiLnRes {
    static constexpr bool PERM = false, AFTER_DRAIN = true;
    const float* base; float* out; int ldc; const float* bias; PanelStats st; unsigned poison;
    __device__ __forceinline__ void fused(f32x4 (&acc)[2][2][4][2], const Unit& u, int wr, int wc, int fr, int fq, PG8_LAS unsigned char* lds, int wid, int lane) const {
        typedef float f32x2v __attribute__((ext_vector_type(2)));
        const PG8_LAS f32x2v* S = (const PG8_LAS f32x2v*)(lds + 8192);
        const int col0 = u.pn * BM + wc * 32 + 4 * fq;
#pragma unroll
        for (int bj = 0; bj < 2; ++bj)
#pragma unroll
            for (int n = 0; n < 2; ++n) { const f32x4 bv = bias ? *(const f32x4*)(bias + col0 + bj * HALF + n * 16) : (f32x4){0.f, 0.f, 0.f, 0.f};
#pragma unroll
                for (int ai = 0; ai < 2; ++ai)
#pragma unroll
                    for (int m = 0; m < 4; ++m) acc[ai][bj][m][n] += bv; }
        f32x4 pre[4][2][2];
#pragma unroll
        for (int m = 0; m < 4; ++m) { const size_t off = (size_t)(u.pm * BM + wr * 64 + m * 16 + fr) * ldc + col0;
#pragma unroll
            for (int bj = 0; bj < 2; ++bj)
#pragma unroll
                for (int n = 0; n < 2; ++n) pre[m][bj][n] = *(const f32x4*)(base + off + bj * HALF + n * 16); }
        const bool bad = st.run(acc, u, wr, wc, fr, fq, lds, wid, lane) || poison != 0u;
        const float qnan = __builtin_nanf("");
#pragma unroll
        for (int ai = 0; ai < 2; ++ai)
#pragma unroll
            for (int m = 0; m < 4; ++m) { const int r = ai * HALF + wr * 64 + m * 16 + fr; const f32x2v sr = S[r]; const size_t off = (size_t)(u.pm * BM + r) * ldc + col0;
#pragma unroll
                for (int bj = 0; bj < 2; ++bj)
#pragma unroll
                    for (int n = 0; n < 2; ++n) { const f32x4 bs = ai == 0 ? pre[m][bj][n] : *(const f32x4*)(base + off + bj * HALF + n * 16); f32x4 o = bs + (acc[ai][bj][m][n] - sr.x) * sr.y;
                        if (bad) o = (f32x4){qnan, qnan, qnan, qnan}; *(f32x4*)(out + off + bj * HALF + n * 16) = o; }
                if (m & 1) asm volatile("" ::: "memory"); }
    }
};
struct EpiLnResLn {
    static constexpr bool PERM = false, AFTER_DRAIN = true;
    const float* base; float* out; bf16_t* xn; int ldc; const float* bias; PanelStats st1, st2; unsigned poison;
    __device__ __forceinline__ void fused(f32x4 (&acc)[2][2][4][2], const Unit& u, int wr, int wc, int fr, int fq, PG8_LAS unsigned char* lds, int wid, int lane) const {
        typedef float f32x2v __attribute__((ext_vector_type(2))); typedef unsigned u32x2v __attribute__((ext_vector_type(2)));
        const PG8_LAS f32x2v* S = (const PG8_LAS f32x2v*)(lds + 8192);
        const int col0 = u.pn * BM + wc * 32 + 4 * fq;
#pragma unroll
        for (int bj = 0; bj < 2; ++bj)
#pragma unroll
            for (int n = 0; n < 2; ++n) { const f32x4 bv = bias ? *(const f32x4*)(bias + col0 + bj * HALF + n * 16) : (f32x4){0.f, 0.f, 0.f, 0.f};
#pragma unroll
                for (int ai = 0; ai < 2; ++ai)
#pragma unroll
                    for (int m = 0; m < 4; ++m) acc[ai][bj][m][n] += bv; }
        bool bad = st1.run(acc, u, wr, wc, fr, fq, lds, wid, lane) || poison != 0u;
        const float qnan = __builtin_nanf("");
#pragma unroll
        for (int ai = 0; ai < 2; ++ai)
#pragma unroll
            for (int m = 0; m < 4; ++m) { const int r = ai * HALF + wr * 64 + m * 16 + fr; const f32x2v sr = S[r]; const size_t off = (size_t)(u.pm * BM + r) * ldc + col0;
#pragma unroll
                for (int bj = 0; bj < 2; ++bj)
#pragma unroll
                    for (int n = 0; n < 2; ++n) { const f32x4 bs = *(const f32x4*)(base + off + bj * HALF + n * 16); acc[ai][bj][m][n] = bs + (acc[ai][bj][m][n] - sr.x) * sr.y; }
                asm volatile("" : "+v"(acc[ai][0][m][0]), "+v"(acc[ai][0][m][1]), "+v"(acc[ai][1][m][0]), "+v"(acc[ai][1][m][1]));
                if (m & 1) asm volatile("" ::: "memory"); }
        const bool bad1 = bad;
        bad = st2.run(acc, u, wr, wc, fr, fq, lds, wid, lane) || bad;
#pragma unroll
        for (int ai = 0; ai < 2; ++ai)
#pragma unroll
            for (int m = 0; m < 4; ++m) { const int r = ai * HALF + wr * 64 + m * 16 + fr; const f32x2v sr = S[r]; const size_t off = (size_t)(u.pm * BM + r) * ldc + col0;
#pragma unroll
                for (int bj = 0; bj < 2; ++bj)
#pragma unroll
                    for (int n = 0; n < 2; ++n) { const f32x4 x1 = acc[ai][bj][m][n]; *(f32x4*)(out + off + bj * HALF + n * 16) = bad1 ? (f32x4){qnan, qnan, qnan, qnan} : x1;
                        const f32x4 o = (x1 - sr.x) * sr.y; u32x2v w; w.x = cvt_pk_bf16(o[0], o[1]); w.y = cvt_pk_bf16(o[2], o[3]);
                        if (bad) { w.x = 0x7fc07fc0u; w.y = 0x7fc07fc0u; } *(u32x2v*)(xn + off + bj * HALF + n * 16) = w; }
                asm volatile("" ::: "memory"); }
    }
};

template <class Epi, class Sched, bool ALIGN_EPI = false, bool SP2 = false>
__device__ __forceinline__ void gemm_phase(PG8_LAS unsigned char* lds, const Gemm g, const Sched& S, const Epi& E) {
    const int tid = threadIdx.x, wid = __builtin_amdgcn_readfirstlane(tid >> 6), lane = tid & 63, wr = wid >> 2, wc = wid & 3, fr = lane & 15, fq = lane >> 4;
    const int K = g.K, nt = K / BK;
    unsigned voffA[2], voffB[2];
#pragma unroll
    for (int i = 0; i < 2; ++i) { int R, C; stage_rc(tid * 16 + i * 8192, R, C); const int Rb = Epi::PERM ? ((R & ~31) + perm32(R & 31)) : R;
        voffA[i] = (unsigned)(R * K + C) * 2u; voffB[i] = (unsigned)(Rb * K + C) * 2u; }
    const size_t kstep = (size_t)(BK * 2);
    const size_t hstep = (size_t)HALF * K * 2;
    const size_t tstep = 2 * hstep;
    const unsigned ldsw = (unsigned)wid * 1024u;
    const int aoff = lds_byte(wr * 64 + fr, fq * 8), boff = lds_byte(wc * 32 + fr, fq * 8);
#define PG8_SA(b, h) (((b) * 2 + (h)) * HTB)
#define PG8_SB(b, h) ((4 + (b) * 2 + (h)) * HTB)
#define PG8_STAGE(bufoff, gbase, voff) do { _Pragma("unroll") for (int _i = 0; _i < 2; ++_i) \
        __builtin_amdgcn_global_load_lds((const unsigned*)((const char*)(gbase) + (voff)[_i]), (PG8_LAS unsigned*)(lds + (bufoff) + ldsw + _i * 8192), 16, 0, 0); } while (0)
#define PG8_LDA(dst, b, h) do { _Pragma("unroll") for (int m = 0; m < 4; ++m) _Pragma("unroll") for (int k = 0; k < 2; ++k) dst[m][k] = *(const PG8_LAS bf16x8*)(lds + PG8_SA(b, h) + aoff + m * 2048 + k * 1024); } while (0)
#define PG8_LDB(dst, b, h) do { _Pragma("unroll") for (int n = 0; n < 2; ++n) _Pragma("unroll") for (int k = 0; k < 2; ++k) dst[n][k] = *(const PG8_LAS bf16x8*)(lds + PG8_SB(b, h) + boff + n * 2048 + k * 1024); } while (0)
#define PG8_MMA(ai, bj, At, Bt) do { __builtin_amdgcn_s_setprio(1); _Pragma("unroll") for (int m = 0; m < 4; ++m) _Pragma("unroll") for (int n = 0; n < 2; ++n) _Pragma("unroll") for (int k = 0; k < 2; ++k) \
        acc[ai][bj][m][n] = __builtin_amdgcn_mfma_f32_16x16x32_bf16(Bt[n][k], At[m][k], acc[ai][bj][m][n], 0, 0, 0); __builtin_amdgcn_s_setprio(0); } while (0)
#define PG8_WAIT_V(n) asm volatile("s_waitcnt vmcnt(" #n ")" ::: "memory")
#define PG8_WAIT_L(n) asm volatile("s_waitcnt lgkmcnt(" #n ")" ::: "memory")
#define PG8_BAR __builtin_amdgcn_s_barrier()
#define PG8_SCHED __builtin_amdgcn_sched_barrier(0)
    Unit cur, nxt; int ui = 0;
    if (!S.next(0, cur)) return;
    f32x4 acc[2][2][4][2];
#pragma unroll
    for (int a = 0; a < 2; ++a)
#pragma unroll
        for (int b = 0; b < 2; ++b)
#pragma unroll
            for (int m = 0; m < 4; ++m)
#pragma unroll
                for (int n = 0; n < 2; ++n) acc[a][b][m][n] = (f32x4){0.f, 0.f, 0.f, 0.f};
    bf16x8 At[4][2], B0[2][2], B1[2][2];
    const char* cA = (const char*)g.A + (size_t)cur.pm * tstep; const char* cB = (const char*)g.Bt + (size_t)cur.pn * tstep;
    S.a_ready(cur);
    if constexpr (SP2) {
        PG8_STAGE(PG8_SB(0, 0), cB, voffB); PG8_STAGE(PG8_SB(0, 1), cB + hstep, voffB); PG8_STAGE(PG8_SA(0, 0), cA, voffA); PG8_STAGE(PG8_SA(0, 1), cA + hstep, voffA);
        if (wr == 1) PG8_BAR;
        PG8_WAIT_V(2); PG8_BAR;
        PG8_STAGE(PG8_SB(1, 0), cB + kstep, voffB); PG8_STAGE(PG8_SA(1, 0), cA + kstep, voffA); PG8_STAGE(PG8_SB(1, 1), cB + hstep + kstep, voffB);
        PG8_WAIT_V(6); PG8_BAR;
    } else {
        PG8_STAGE(PG8_SB(0, 0), cB, voffB); PG8_STAGE(PG8_SA(0, 0), cA, voffA); PG8_STAGE(PG8_SB(0, 1), cB + hstep, voffB); PG8_STAGE(PG8_SA(0, 1), cA + hstep, voffA);
        if (wr == 1) PG8_BAR;
        PG8_WAIT_V(4); PG8_BAR;
        PG8_STAGE(PG8_SB(1, 0), cB + kstep, voffB); PG8_STAGE(PG8_SA(1, 0), cA + kstep, voffA); PG8_STAGE(PG8_SB(1, 1), cB + hstep + kstep, voffB);
        PG8_WAIT_V(6); PG8_BAR;
    }
    for (;;) {
        const bool has_next = S.next(ui + 1, nxt);
        const char* nA = has_next ? (const char*)g.A + (size_t)nxt.pm * tstep : cA; const char* nB = has_next ? (const char*)g.Bt + (size_t)nxt.pn * tstep : cB;
        for (int t = 0; t < nt; t += 2) {
            const bool last = (t == nt - 2);
            const char* a1 = cA + (size_t)(t + 1) * kstep;
            const char* a2 = last ? nA : cA + (size_t)(t + 2) * kstep; const char* b2 = last ? nB : cB + (size_t)(t + 2) * kstep;
            const char* a3 = a2 + kstep; const char* b3 = b2 + kstep;
            if (last && has_next) S.a_ready(nxt);
            if constexpr (SP2) {
            PG8_LDB(B0, 0, 0); PG8_LDB(B1, 0, 1); PG8_SCHED; PG8_LDA(At, 0, 0); PG8_STAGE(PG8_SA(1, 1), a1 + hstep, voffA);
            PG8_WAIT_V(8); PG8_WAIT_L(0); PG8_BAR; PG8_MMA(0, 0, At, B0); PG8_MMA(0, 1, At, B1); PG8_BAR; PG8_SCHED;
            PG8_LDA(At, 0, 1); PG8_STAGE(PG8_SB(0, 0), b2, voffB); PG8_STAGE(PG8_SB(0, 1), b2 + hstep, voffB); PG8_STAGE(PG8_SA(0, 0), a2, voffA);
            PG8_WAIT_V(8); PG8_WAIT_L(0); PG8_BAR; PG8_MMA(1, 0, At, B0); PG8_MMA(1, 1, At, B1); PG8_BAR; PG8_SCHED;
            PG8_LDB(B0, 1, 0); PG8_LDB(B1, 1, 1); PG8_SCHED; PG8_LDA(At, 1, 0); PG8_STAGE(PG8_SA(0, 1), a2 + hstep, voffA);
            PG8_WAIT_V(8); PG8_WAIT_L(0); PG8_BAR; PG8_MMA(0, 0, At, B0); PG8_MMA(0, 1, At, B1); PG8_BAR; PG8_SCHED;
            PG8_LDA(At, 1, 1); PG8_STAGE(PG8_SB(1, 0), b3, voffB); PG8_STAGE(PG8_SB(1, 1), b3 + hstep, voffB); PG8_STAGE(PG8_SA(1, 0), a3, voffA);
            PG8_WAIT_V(8); PG8_WAIT_L(0); PG8_BAR; PG8_MMA(1, 0, At, B0); PG8_MMA(1, 1, At, B1); PG8_BAR; PG8_SCHED;
            } else {
            PG8_LDB(B0, 0, 0); PG8_SCHED; PG8_LDA(At, 0, 0); PG8_STAGE(PG8_SA(1, 1), a1 + hstep, voffA);
            PG8_WAIT_L(8); PG8_BAR; PG8_WAIT_L(0); PG8_MMA(0, 0, At, B0); PG8_BAR; PG8_SCHED;
            PG8_LDB(B1, 0, 1); PG8_STAGE(PG8_SB(0, 0), b2, voffB);
            PG8_BAR; PG8_WAIT_L(0); PG8_MMA(0, 1, At, B1); PG8_BAR;
            PG8_LDA(At, 0, 1); PG8_STAGE(PG8_SA(0, 0), a2, voffA);
            PG8_BAR; PG8_WAIT_L(0); PG8_MMA(1, 0, At, B0); PG8_BAR; PG8_SCHED;
            PG8_STAGE(PG8_SB(0, 1), b2 + hstep, voffB);
            PG8_WAIT_V(6); PG8_BAR; PG8_MMA(1, 1, At, B1); PG8_BAR;
            PG8_LDB(B0, 1, 0); PG8_SCHED; PG8_LDA(At, 1, 0); PG8_STAGE(PG8_SA(0, 1), a2 + hstep, voffA);
            PG8_WAIT_L(8); PG8_BAR; PG8_WAIT_L(0); PG8_MMA(0, 0, At, B0); PG8_BAR; PG8_SCHED;
            PG8_LDB(B1, 1, 1); PG8_STAGE(PG8_SB(1, 0), b3, voffB);
            PG8_BAR; PG8_WAIT_L(0); PG8_MMA(0, 1, At, B1); PG8_BAR;
            PG8_LDA(At, 1, 1); PG8_STAGE(PG8_SA(1, 0), a3, voffA);
            PG8_BAR; PG8_WAIT_L(0); PG8_MMA(1, 0, At, B0); PG8_BAR; PG8_SCHED;
            PG8_STAGE(PG8_SB(1, 1), b3 + hstep, voffB);
            PG8_WAIT_V(6); PG8_BAR; PG8_MMA(1, 1, At, B1); PG8_BAR;
            }
        }
        if constexpr (ALIGN_EPI) { if (wr == 0) PG8_BAR; }
        if constexpr (!Epi::AFTER_DRAIN) { E(acc, cur, wr, wc, fr, fq); S.done(cur); }
        if (!has_next) break;
#pragma unroll
        for (int a = 0; a < 2; ++a)
#pragma unroll
            for (int b = 0; b < 2; ++b)
#pragma unroll
                for (int m = 0; m < 4; ++m)
#pragma unroll
                    for (int n = 0; n < 2; ++n) acc[a][b][m][n] = (f32x4){0.f, 0.f, 0.f, 0.f};
        cur = nxt; cA = nA; cB = nB; ++ui;
        if constexpr (ALIGN_EPI) { if (wr == 1) PG8_BAR; }
    }
    PG8_WAIT_V(0);
    if constexpr (!ALIGN_EPI) { if (wr == 0) PG8_BAR; }
    PG8_BAR;
    if constexpr (Epi::AFTER_DRAIN) { E.fused(acc, cur, wr, wc, fr, fq, lds, wid, lane); S.done(cur); }
#undef PG8_SA
#undef PG8_SB
#undef PG8_STAGE
#undef PG8_LDA
#undef PG8_LDB
#undef PG8_MMA
#undef PG8_WAIT_V
#undef PG8_WAIT_L
#undef PG8_BAR
#undef PG8_SCHED
}
}

#ifndef PG8_SP2
#define PG8_SP2 true
#endif
#ifndef PG8_ALIGN
#define PG8_ALIGN true
#endif

constexpr int NWAVES = 8;
constexpr int BATCH = 4, T = 4096, D = 1024, M = BATCH * T;
constexpr int FF = 2816, NFF_IN = 2 * FF;
constexpr int POOLW = 512, DNW = 1024, NH = 8, HD = 128;
constexpr int MIXW = 6672;
constexpr int NM1 = 3840;
constexpr int NMOD = 9216;
constexpr float RMS_EPS = 1e-6f, L2_EPS = 1e-6f;

constexpr size_t MiB = 1u << 20;
constexpr size_t WS_CTL = 0, CTL_ZERO_BYTES = 1 * MiB;
constexpr size_t WS_W1IN = 1 * MiB;
constexpr size_t WS_W1OUT = 12 * MiB;
constexpr size_t WS_W2IN = WS_W1OUT + 5632 * 1024;
constexpr size_t WS_W2OUT = WS_W2IN + 11 * MiB;
constexpr size_t WS_WM1 = WS_W2OUT + 5632 * 1024;
constexpr size_t WS_WZ = WS_WM1 + (size_t)NM1 * 1024 * 2;
constexpr size_t WS_WG = WS_WZ + 2 * MiB;
constexpr size_t WS_WPP = WS_WG + 4 * MiB;
constexpr size_t WS_WDN = WS_WPP + 1 * MiB;
constexpr size_t WS_WMO2 = WS_WDN + 2 * MiB;
constexpr size_t WS_MOD = WS_WMO2 + 4 * MiB;
constexpr size_t WS_BIG = 56 * MiB;
constexpr size_t WS_H = 224 * MiB;
constexpr size_t WS_END = 256 * MiB;
constexpr size_t WS_HID = WS_BIG;
constexpr size_t WS_QKV = WS_BIG;
constexpr size_t WS_XP = WS_QKV + 96 * MiB;
constexpr size_t WS_POOLED = WS_XP + 16 * MiB;
constexpr size_t WS_ONORM = WS_POOLED + 16 * MiB;
constexpr size_t WS_BETA = WS_ONORM + 32 * MiB;
constexpr size_t WS_GL = WS_BETA + MiB / 2;
constexpr size_t WS_GATES = WS_BIG;
constexpr size_t WS_OG = WS_GATES + 64 * MiB;
constexpr size_t WS_WPP32 = WS_XP;
constexpr size_t WS_TAB = WS_ONORM;
static_assert(WS_MOD + 4 * 9216 * 4 <= WS_BIG && WS_GL + MiB / 2 <= WS_H && WS_TAB + 64 * MiB <= WS_END && WS_HID + 88 * MiB <= WS_H, "d_ws map");

constexpr int RING_OFF = 0, RING_BYTES = 131072;
constexpr int LDSCTL_OFF = RING_BYTES, MISC_OFF = LDSCTL_OFF + 320;
constexpr int LDS_BYTES = 147456;

#define GAS __attribute__((address_space(1)))
#define LAS __attribute__((address_space(3)))
typedef unsigned short bf16;
typedef unsigned v4u __attribute__((ext_vector_type(4)));
typedef unsigned v2u __attribute__((ext_vector_type(2)));
typedef float f32x4 __attribute__((ext_vector_type(4)));
#define LDS_WAIT() asm volatile("s_waitcnt lgkmcnt(0)" ::: "memory")
#define VM_WAIT() asm volatile("s_waitcnt vmcnt(0)" ::: "memory")
__device__ __forceinline__ unsigned f2bf(float f) { unsigned u = __builtin_bit_cast(unsigned, f); return (u + 0x7fffu + ((u >> 16) & 1u)) >> 16; }
__device__ __forceinline__ unsigned pk2(float lo, float hi) { return f2bf(lo) | (f2bf(hi) << 16); }
__device__ __forceinline__ float bf2f(unsigned short b) { return __builtin_bit_cast(float, (unsigned)b << 16); }
__device__ __forceinline__ float bflo(unsigned w) { return __builtin_bit_cast(float, w << 16); }
__device__ __forceinline__ float bfhi(unsigned w) { return __builtin_bit_cast(float, w & 0xffff0000u); }
__device__ __forceinline__ float fast_sigmoid(float x) { return __builtin_amdgcn_rcpf(1.0f + __builtin_amdgcn_exp2f(-1.4426950408889634f * x)); }
__device__ __forceinline__ float fast_silu(float x) { return x * fast_sigmoid(x); }
__device__ __forceinline__ float wave_sum(float v) {
#pragma unroll
    for (int o = 1; o < 64; o <<= 1) v += __shfl_xor(v, o);
    return v;
}

typedef GAS unsigned gu32;
typedef GAS unsigned long long gu64;
#define RLX_AGENT __ATOMIC_RELAXED, __HIP_MEMORY_SCOPE_AGENT
#define XB_TMO      128
#define XB_XCNT(j)  (256  + 64 * (j))
#define XB_XSUB(j)  (1280 + 64 * (j))
#define XB_XGEN(j)  (2304 + 64 * (j))
#define XB_TOP      3328
#define XB_TOPGEN   3392
#define XCD_BAR_WORDS 3456
#define XB_SPIN_CAP (1u << 18)

__device__ __forceinline__ unsigned xb_ld(unsigned* p)              { return __hip_atomic_load(p, __ATOMIC_RELAXED, __HIP_MEMORY_SCOPE_AGENT); }
__device__ __forceinline__ unsigned xb_add(unsigned* p, unsigned v) { return __hip_atomic_fetch_add(p, v, __ATOMIC_RELAXED, __HIP_MEMORY_SCOPE_AGENT); }
__device__ __forceinline__ unsigned xb_xcc_id() { return (unsigned)__builtin_amdgcn_s_getreg((3 << 11) | 20) & 0xFu; }
#define XB_SPIN(cond, bar) do { unsigned _sp = 0; while (cond) { __builtin_amdgcn_s_sleep(1); \
    if ((++_sp & 255u) == 0u) { if (xb_ld(&(bar)[XB_TMO])) break; if (_sp > XB_SPIN_CAP) { atomicAdd(&(bar)[XB_TMO], 1u); break; } } } } while (0)

struct XcdBarrier {
    unsigned* bar; unsigned x;
    volatile LAS unsigned* st;
};

__device__ __forceinline__ XcdBarrier xcd_barrier_post(unsigned* bar, volatile LAS unsigned* st) {
    XcdBarrier b; b.bar = bar; b.x = xb_xcc_id(); b.st = st;
    if (threadIdx.x == 0) (void)xb_add(&bar[XB_XCNT(b.x)], 1u);
    return b;
}
__device__ __forceinline__ void xcd_barrier_complete(unsigned* bar, unsigned x, unsigned& nloc, unsigned& nx) {
    const unsigned G = gridDim.x * gridDim.y * gridDim.z;
    unsigned sum, cnt, mine, sp = 0u;
    for (;;) {
        sum = 0u; cnt = 0u; mine = 0u;
#pragma unroll
        for (unsigned j = 0; j < 16; ++j) { const unsigned c = xb_ld(&bar[XB_XCNT(j)]); sum += c; cnt += (c > 0u) ? 1u : 0u; mine = (j == x) ? c : mine; }
        if (sum == G) break;
        __builtin_amdgcn_s_sleep(1);
        if ((++sp & 255u) == 0u) { if (xb_ld(&bar[XB_TMO])) break; if (sp > XB_SPIN_CAP) { atomicAdd(&bar[XB_TMO], 1u); break; } }
    }
    nloc = mine > 0u ? mine : 1u; nx = cnt > 0u ? cnt : 1u;
}

__device__ __forceinline__ void xcd_barrier(const XcdBarrier& b) {
    asm volatile("s_waitcnt vmcnt(0)" ::: "memory");
    __syncthreads();
    if (threadIdx.x == 0) {
        unsigned* bar = b.bar;
        __builtin_amdgcn_s_waitcnt(0);
        unsigned nloc = b.st[0], nx = b.st[1];
        if (nloc == 0u) { xcd_barrier_complete(bar, b.x, nloc, nx); b.st[0] = nloc; b.st[1] = nx; }
        const unsigned old = xb_add(&bar[XB_XSUB(b.x)], 1u);
        const unsigned gen = old / nloc;
        if (old + 1u == (gen + 1u) * nloc) {
            __builtin_amdgcn_fence(__ATOMIC_RELEASE, "agent");
            asm volatile("s_waitcnt vmcnt(0)" ::: "memory");
            const unsigned og = xb_add(&bar[XB_TOP], 1u);
            const unsigned tg = og / nx;
            if (og + 1u == (tg + 1u) * nx) xb_add(&bar[XB_TOPGEN], 1u);
            else XB_SPIN(xb_ld(&bar[XB_TOPGEN]) == tg, bar);
            __builtin_amdgcn_fence(__ATOMIC_ACQUIRE, "agent");
            xb_add(&bar[XB_XGEN(b.x)], 1u);
            asm volatile("s_waitcnt vmcnt(0)" ::: "memory");
        } else {
            XB_SPIN(xb_ld(&bar[XB_XGEN(b.x)]) == gen, bar);
            __builtin_amdgcn_fence(__ATOMIC_ACQUIRE, "agent");
            asm volatile("s_waitcnt vmcnt(0)" ::: "memory");
        }
    }
    __syncthreads();
}

constexpr int CW_TMO = 0, CW_BAR = 4096;
namespace pg8 {
struct EpiSwiglu {
    static constexpr bool PERM = true, AFTER_DRAIN = false;
    bf16_t* O; int ldc;
    __device__ __forceinline__ void operator()(const f32x4 (&acc)[2][2][4][2], const Unit& u, int wr, int wc, int fr, int fq) const {
        const int row0 = u.pm * BM + wr * 64 + fr, col0 = u.pn * HALF + wc * 32 + 8 * fq;
#pragma unroll
        for (int ai = 0; ai < 2; ++ai)
#pragma unroll
            for (int m = 0; m < 4; ++m) {
                bf16_t* rowp = O + (size_t)(row0 + ai * HALF + m * 16) * ldc + col0;
                float h[8];
#pragma unroll
                for (int n = 0; n < 2; ++n)
#pragma unroll
                    for (int j = 0; j < 4; ++j) h[4 * n + j] = fast_silu(acc[ai][0][m][n][j]) * acc[ai][1][m][n][j];
                u32x4 w; w.x = cvt_pk_bf16(h[0], h[1]); w.y = cvt_pk_bf16(h[2], h[3]); w.z = cvt_pk_bf16(h[4], h[5]); w.w = cvt_pk_bf16(h[6], h[7]);
                *(u32x4*)rowp = w;
            }
    }
};
struct EpiResGate {
    static constexpr bool PERM = false, AFTER_DRAIN = false;
    const float* base; float* out; int ldc; const float* gate; int gate_bstride; float coef;
    __device__ __forceinline__ void operator()(const f32x4 (&acc)[2][2][4][2], const Unit& u, int wr, int wc, int fr, int fq) const {
        const int row0 = u.pm * BM + wr * 64 + fr, col0 = u.pn * BM + wc * 32 + 4 * fq;
        const float* gp = gate + (size_t)((u.pm * BM) / 4096) * gate_bstride + col0;
        f32x4 gv[2][2];
#pragma unroll
        for (int bj = 0; bj < 2; ++bj)
#pragma unroll
            for (int n = 0; n < 2; ++n) gv[bj][n] = *(const f32x4*)(gp + bj * HALF + n * 16) * coef;
#pragma unroll
        for (int ai = 0; ai < 2; ++ai)
#pragma unroll
            for (int m = 0; m < 4; ++m) {
                const size_t off = (size_t)(row0 + ai * HALF + m * 16) * ldc + col0;
#pragma unroll
                for (int bj = 0; bj < 2; ++bj)
#pragma unroll
                    for (int n = 0; n < 2; ++n) { const f32x4 bs = *(const f32x4*)(base + off + bj * HALF + n * 16); *(f32x4*)(out + off + bj * HALF + n * 16) = bs + gv[bj][n] * acc[ai][bj][m][n]; }
            }
    }
};
struct EpiM1 {
    static constexpr bool PERM = true, AFTER_DRAIN = false;
    bf16_t* qkv; bf16_t* xp; float* beta; float* gl; const float* a_log; const float* dt_bias;
    __device__ __forceinline__ void operator()(const f32x4 (&acc)[2][2][4][2], const Unit& u, int wr, int wc, int fr, int fq) const {
        const int row0 = u.pm * BM + wr * 64 + fr;
        if (u.pn < 14) {
            bf16_t* base; int ldc, colt;
            if (u.pn < 12) { base = qkv; ldc = 3072; colt = u.pn * BM; } else { base = xp; ldc = 512; colt = (u.pn - 12) * BM; }
            const int col0 = colt + wc * 32 + 8 * fq;
#pragma unroll
            for (int ai = 0; ai < 2; ++ai)
#pragma unroll
                for (int m = 0; m < 4; ++m) { bf16_t* rowp = base + (size_t)(row0 + ai * HALF + m * 16) * ldc + col0;
#pragma unroll
                    for (int bj = 0; bj < 2; ++bj) { const f32x4 v0 = acc[ai][bj][m][0], v1 = acc[ai][bj][m][1];
                        u32x4 w; w.x = cvt_pk_bf16(v0[0], v0[1]); w.y = cvt_pk_bf16(v0[2], v0[3]); w.z = cvt_pk_bf16(v1[0], v1[1]); w.w = cvt_pk_bf16(v1[2], v1[3]);
                        *(u32x4*)(rowp + bj * HALF) = w; } }
        } else if (wc == 0 && fq < 2) {
            float al[8], db[8];
#pragma unroll
            for (int h = 0; h < 8; ++h) { al[h] = -expf(a_log[h]); db[h] = dt_bias[h]; }
#pragma unroll
            for (int ai = 0; ai < 2; ++ai)
#pragma unroll
                for (int m = 0; m < 4; ++m) { const size_t r = (size_t)(row0 + ai * HALF + m * 16);
#pragma unroll
                    for (int n = 0; n < 2; ++n) { const f32x4 v = acc[ai][0][m][n]; f32x4 o;
                        if (fq == 0) {
#pragma unroll
                            for (int j = 0; j < 4; ++j) o[j] = 1.0f / (1.0f + expf(-v[j]));
                            *(f32x4*)(beta + r * 8 + 4 * n) = o;
                        } else {
#pragma unroll
                            for (int j = 0; j < 4; ++j) { const float xx = v[j] + db[4 * n + j]; const float sp = xx > 20.f ? xx : log1pf(expf(xx)); o[j] = al[4 * n + j] * sp; }
                            *(f32x4*)(gl + r * 8 + 4 * n) = o;
                        } } }
        }
    }
};
struct EpiSigmoid {
    static constexpr bool PERM = true, AFTER_DRAIN = false;
    bf16_t* O; int ldc;
    __device__ __forceinline__ void operator()(const f32x4 (&acc)[2][2][4][2], const Unit& u, int wr, int wc, int fr, int fq) const {
        const int row0 = u.pm * BM + wr * 64 + fr, col0 = u.pn * BM + wc * 32 + 8 * fq;
#pragma unroll
        for (int ai = 0; ai < 2; ++ai)
#pragma unroll
            for (int m = 0; m < 4; ++m) { bf16_t* rowp = O + (size_t)(row0 + ai * HALF + m * 16) * ldc + col0;
#pragma unroll
                for (int bj = 0; bj < 2; ++bj) { const f32x4 v0 = acc[ai][bj][m][0], v1 = acc[ai][bj][m][1];
                    u32x4 w; w.x = cvt_pk_bf16(fast_sigmoid(v0[0]), fast_sigmoid(v0[1])); w.y = cvt_pk_bf16(fast_sigmoid(v0[2]), fast_sigmoid(v0[3]));
                    w.z = cvt_pk_bf16(fast_sigmoid(v1[0]), fast_sigmoid(v1[1])); w.w = cvt_pk_bf16(fast_sigmoid(v1[2]), fast_sigmoid(v1[3]));
                    *(u32x4*)(rowp + bj * HALF) = w; } }
    }
};
template <int ACT> struct EpiMulBf16 {
    static constexpr bool PERM = true, AFTER_DRAIN = false;
    const bf16_t* F; int ldf; bf16_t* O; int ldc;
    __device__ __forceinline__ void operator()(const f32x4 (&acc)[2][2][4][2], const Unit& u, int wr, int wc, int fr, int fq) const {
        const int row0 = u.pm * BM + wr * 64 + fr, col0 = u.pn * BM + wc * 32 + 8 * fq;
#pragma unroll
        for (int ai = 0; ai < 2; ++ai)
#pragma unroll
            for (int m = 0; m < 4; ++m) { const size_t r = (size_t)(row0 + ai * HALF + m * 16);
#pragma unroll
                for (int bj = 0; bj < 2; ++bj) { const f32x4 v0 = acc[ai][bj][m][0], v1 = acc[ai][bj][m][1];
                    const u32x4 f = *(const u32x4*)(F + r * ldf + col0 + bj * HALF);
                    float a[8] = {v0[0], v0[1], v0[2], v0[3], v1[0], v1[1], v1[2], v1[3]};
                    if (ACT == 1) {
#pragma unroll
                        for (int j = 0; j < 8; ++j) a[j] = fast_silu(a[j]);
                    }
                    u32x4 w; w.x = cvt_pk_bf16(bflo(f.x) * a[0], bfhi(f.x) * a[1]); w.y = cvt_pk_bf16(bflo(f.y) * a[2], bfhi(f.y) * a[3]);
                    w.z = cvt_pk_bf16(bflo(f.z) * a[4], bfhi(f.z) * a[5]); w.w = cvt_pk_bf16(bflo(f.w) * a[6], bfhi(f.w) * a[7]);
                    *(u32x4*)(O + r * ldc + col0 + bj * HALF) = w; } }
    }
};
}

struct Frame {
    LAS unsigned char* lds;
    volatile LAS unsigned* MISC; gu32* ctl;
    int tid, lane, wave, G, vcu;
    const float* in[20]; float* out; unsigned char* ws;
};

__device__ __forceinline__ void tr_item(const float* W, int ld_src, int k0, int c0, bf16* WT, int ld_dst, int r0, int dk0, LAS float* scr, int lane) {
#pragma unroll 8
    for (int i = 0; i < 32; ++i) { const int kk = 2 * i + (lane >> 5); scr[kk * 33 + (lane & 31)] = W[(size_t)(k0 + kk) * ld_src + c0 + (lane & 31)]; }
    LDS_WAIT(); asm volatile("" ::: "memory");
    const int c = lane & 7;
#pragma unroll
    for (int j = 0; j < 4; ++j) { const int n = (lane >> 3) + 8 * j; const LAS float* s = scr + (8 * c) * 33 + n;
        v4u o; o.x = pk2(s[0 * 33], s[1 * 33]); o.y = pk2(s[2 * 33], s[3 * 33]); o.z = pk2(s[4 * 33], s[5 * 33]); o.w = pk2(s[6 * 33], s[7 * 33]);
        *(GAS v4u*)(WT + (size_t)(r0 + n) * ld_dst + dk0 + k0 + 8 * c) = o; }
    LDS_WAIT(); asm volatile("" ::: "memory");
}

__device__ __forceinline__ void p0_prologue(Frame& F) {
    LAS float* scr = (LAS float*)(F.lds + RING_OFF + F.wave * 16384);
    const int gw = F.vcu * NWAVES + F.wave, NGW = F.G * NWAVES;
    unsigned char* ws = F.ws;
    constexpr int I_FIN = (D / 64) * (NFF_IN / 32);
    constexpr int I_FOUT = (FF / 64) * (D / 32);
    constexpr int I_QKV = (D / 64) * (3072 / 32);
    constexpr int I_XP = (D / 64) * (512 / 32);
    constexpr int I_Z = (D / 64) * (1024 / 32);
    constexpr int I_G = (D / 64) * (2048 / 32);
    constexpr int I_SQ = (D / 64) * (D / 32);
    constexpr int NITEMS = 2 * I_FIN + 2 * I_FOUT + I_QKV + I_XP + I_Z + I_G + 3 * I_SQ;
    for (int it = gw; it < NITEMS; it += NGW) {
        int r = it;
        if (r < 2 * I_FIN) { const int which = r / I_FIN; r -= which * I_FIN; const int kb = r / 176, cb = r % 176;
            const int half = cb / 88, c2 = cb % 88, p = c2 / 4, w = c2 % 4;
            tr_item((which ? F.in[7] : F.in[5]), NFF_IN, 64 * kb, 32 * cb, (bf16*)(ws + (which ? WS_W2IN : WS_W1IN)), D, 256 * p + 128 * half + 32 * w, 0, scr, F.lane); continue; }
        r -= 2 * I_FIN;
        if (r < 2 * I_FOUT) { const int which = r / I_FOUT; r -= which * I_FOUT; const int kb = r / 32, cb = r % 32;
            tr_item((which ? F.in[8] : F.in[6]), D, 64 * kb, 32 * cb, (bf16*)(ws + (which ? WS_W2OUT : WS_W1OUT)), FF, 32 * cb, 0, scr, F.lane); continue; }
        r -= 2 * I_FOUT;
        if (r < I_QKV) { const int kb = r / 96, cb = r % 96; tr_item(F.in[9], MIXW, 64 * kb, 512 + 32 * cb, (bf16*)(ws + WS_WM1), D, 32 * cb, 0, scr, F.lane); continue; }
        r -= I_QKV;
        if (r < I_XP) { const int kb = r / 16, cb = r % 16; tr_item(F.in[9], MIXW, 64 * kb, 32 * cb, (bf16*)(ws + WS_WM1), D, 3072 + 32 * cb, 0, scr, F.lane); continue; }
        r -= I_XP;
        if (r < I_Z) { const int kb = r / 32, cb = r % 32; tr_item(F.in[9], MIXW, 64 * kb, 3584 + 32 * cb, (bf16*)(ws + WS_WZ), D, 32 * cb, 0, scr, F.lane); continue; }
        r -= I_Z;
        if (r < I_G) { const int kb = r / 64, cb = r % 64; tr_item(F.in[9], MIXW, 64 * kb, 4624 + 32 * cb, (bf16*)(ws + WS_WG), D, 32 * cb, 0, scr, F.lane); continue; }
        r -= I_G;
        { const int which = r / I_SQ; r -= which * I_SQ; const int kb = r / 32, cb = r % 32;
          if (which == 0) tr_item(F.in[17], D, 64 * kb, 32 * cb, (bf16*)(ws + WS_WDN), D, 32 * cb, 0, scr, F.lane);
          else tr_item(F.in[18], D, 64 * kb, 32 * cb, (bf16*)(ws + WS_WMO2), 2 * D, 32 * cb, (which - 1) * D, scr, F.lane); }
    }
    {
        bf16* wm1 = (bf16*)(ws + WS_WM1);
        for (int it = gw; it < 16 * 16; it += NGW) { const int n = it & 15, k = (it >> 4) * 64 + F.lane; wm1[(size_t)(3584 + n) * D + k] = (bf16)f2bf(F.in[9][(size_t)k * MIXW + 4608 + n]); }
        for (int it = gw; it < 240 * D / 8 / 64; it += NGW) *(GAS v4u*)(wm1 + (size_t)3600 * D + ((size_t)it * 64 + F.lane) * 8) = (v4u){0u, 0u, 0u, 0u};
    }
    {
        const float* pw = F.in[14]; const float* ps = F.in[15]; const float* pp = F.in[16];
        float* wpp32 = (float*)(ws + WS_WPP32);
        for (int it = gw; it < 512 * 16; it += NGW) {
            const int k = it >> 4, g = k >> 7, n = (it & 15) * 64 + F.lane;
            float a = 0.f;
#pragma unroll 8
            for (int d = 0; d < 128; ++d) a += (pw[(size_t)k * 128 + d] * ps[g * 128 + d]) * pp[(size_t)(g * 128 + d) * D + n];
            wpp32[(size_t)k * D + n] = a;
        }
    }
    {
        __syncthreads();
        LAS float* sc = (LAS float*)(F.lds + 65536);
        LAS float* red = (LAS float*)(F.lds);
        for (int e = F.tid; e < 4 * D; e += NWAVES * 64) { const float cv = F.in[1][e]; sc[e] = cv / (1.0f + expf(-cv)); }
        __syncthreads();
        const float* aw = F.in[2]; const float* ab = F.in[3]; float* mod = (float*)(ws + WS_MOD);
        for (int it = F.vcu; it < NMOD / 64; it += F.G) {
            const int n = it * 64 + F.lane; float a0 = 0.f, a1 = 0.f, a2 = 0.f, a3 = 0.f;
#pragma unroll 16
            for (int kk = 0; kk < 128; ++kk) { const int k = F.wave * 128 + kk; const float w = aw[(size_t)k * NMOD + n];
                a0 += sc[k] * w; a1 += sc[D + k] * w; a2 += sc[2 * D + k] * w; a3 += sc[3 * D + k] * w; }
            red[(F.wave * 4 + 0) * 64 + F.lane] = a0; red[(F.wave * 4 + 1) * 64 + F.lane] = a1; red[(F.wave * 4 + 2) * 64 + F.lane] = a2; red[(F.wave * 4 + 3) * 64 + F.lane] = a3;
            __syncthreads();
            if (F.tid < 256) { const int b = F.tid >> 6, l = F.tid & 63; float s = ab[it * 64 + l];
#pragma unroll
                for (int w = 0; w < 8; ++w) s += red[(w * 4 + b) * 64 + l];
                mod[(size_t)b * NMOD + it * 64 + l] = s; }
            __syncthreads();
        }
    }
}

__device__ __forceinline__ void normmod_rows(Frame& F, const float* X, bf16* H, const float* g, int sub) {
    const int gw = F.vcu * NWAVES + F.wave, NGW = F.G * NWAVES;
    const float* mod = (const float*)(F.ws + WS_MOD);
    for (int m = gw; m < M; m += NGW) {
        const GAS f32x4* xr = (const GAS f32x4*)(X + (size_t)m * D) + F.lane;
        f32x4 v[4]; float s = 0.f;
#pragma unroll
        for (int j = 0; j < 4; ++j) { v[j] = xr[64 * j]; s += (v[j].x * v[j].x + v[j].y * v[j].y) + (v[j].z * v[j].z + v[j].w * v[j].w); }
        const float rs = 1.0f / sqrtf(wave_sum(s) * (1.f / D) + RMS_EPS);
        const float* mb = mod + (size_t)(m / T) * NMOD + sub * 3 * D;
        GAS v2u* o8 = (GAS v2u*)(H + (size_t)m * D) + F.lane;
#pragma unroll
        for (int j = 0; j < 4; ++j) { const int col = 4 * (64 * j + F.lane);
            const f32x4 gg = *(const f32x4*)(g + col), sh = *(const f32x4*)(mb + col), sc = *(const f32x4*)(mb + D + col);
            const f32x4 o = (v[j] * rs * gg) * (sc + 1.0f) + sh;
            v2u w; w.x = pk2(o.x, o.y); w.y = pk2(o.z, o.w); o8[64 * j] = w; }
    }
}
__device__ __forceinline__ void final_norm_rows(Frame& F, const float* X, float* O, const float* g) {
    const int gw = F.vcu * NWAVES + F.wave, NGW = F.G * NWAVES;
    for (int m = gw; m < M; m += NGW) {
        const GAS f32x4* xr = (const GAS f32x4*)(X + (size_t)m * D) + F.lane;
        f32x4 v[4]; float s = 0.f;
#pragma unroll
        for (int j = 0; j < 4; ++j) { v[j] = xr[64 * j]; s += (v[j].x * v[j].x + v[j].y * v[j].y) + (v[j].z * v[j].z + v[j].w * v[j].w); }
        const float rs = 1.0f / sqrtf(wave_sum(s) * (1.f / D) + RMS_EPS);
        GAS f32x4* orow = (GAS f32x4*)(O + (size_t)m * D) + F.lane;
#pragma unroll
        for (int j = 0; j < 4; ++j) { const f32x4 gg = *(const f32x4*)(g + 4 * (64 * j + F.lane)); orow[64 * j] = v[j] * rs * gg; }
    }
}
__device__ __forceinline__ void pool_phase(Frame& F) {
    const bf16* xp = (const bf16*)(F.ws + WS_XP); bf16* pooled = (bf16*)(F.ws + WS_POOLED);
    const int gw = F.vcu * NWAVES + F.wave, NGW = F.G * NWAVES;
    const int c0 = F.lane * 8, w = 2 << (F.lane >> 4);
    for (int ch = gw; ch < M / 64; ch += NGW) {
        const int row0 = ch * 64, t0 = row0 % T;
        float sum[8] = {0.f, 0.f, 0.f, 0.f, 0.f, 0.f, 0.f, 0.f};
        for (int s = 15; s >= 1; --s) {
            if (s <= w - 1 && t0 - s >= 0) { const v4u x = *(const GAS v4u*)(xp + (size_t)(row0 - s) * POOLW + c0);
                sum[0] += bflo(x.x); sum[1] += bfhi(x.x); sum[2] += bflo(x.y); sum[3] += bfhi(x.y); sum[4] += bflo(x.z); sum[5] += bfhi(x.z); sum[6] += bflo(x.w); sum[7] += bfhi(x.w); }
        }
        for (int i = 0; i < 64; ++i) {
            const int t = t0 + i; const v4u x = *(const GAS v4u*)(xp + (size_t)(row0 + i) * POOLW + c0);
            float xv[8] = {bflo(x.x), bfhi(x.x), bflo(x.y), bfhi(x.y), bflo(x.z), bfhi(x.z), bflo(x.w), bfhi(x.w)};
            const float inv = 1.0f / (float)((t + 1) < w ? (t + 1) : w);
            float o[8];
#pragma unroll
            for (int j = 0; j < 8; ++j) { sum[j] += xv[j]; o[j] = sum[j] * inv - xv[j]; }
            v4u ov; ov.x = pk2(o[0], o[1]); ov.y = pk2(o[2], o[3]); ov.z = pk2(o[4], o[5]); ov.w = pk2(o[6], o[7]);
            *(GAS v4u*)(pooled + (size_t)(row0 + i) * POOLW + c0) = ov;
            if (t - w + 1 >= 0) { const v4u y = *(const GAS v4u*)(xp + (size_t)(row0 + i - w + 1) * POOLW + c0);
                sum[0] -= bflo(y.x); sum[1] -= bfhi(y.x); sum[2] -= bflo(y.y); sum[3] -= bfhi(y.y); sum[4] -= bflo(y.z); sum[5] -= bfhi(y.z); sum[6] -= bflo(y.w); sum[7] -= bfhi(y.w); }
        }
    }
}

__device__ __forceinline__ void dn_naive_phase(Frame& F) {
    if ((int)blockIdx.x >= 32) return;
    const bf16* qkv = (const bf16*)(F.ws + WS_QKV); const float* conv_w = F.in[10]; const float* beta = (const float*)(F.ws + WS_BETA); const float* gl = (const float*)(F.ws + WS_GL);
    const float* dn_g = F.in[13]; bf16* onorm = (bf16*)(F.ws + WS_ONORM);
    LAS float* qs = (LAS float*)(F.lds); LAS float* ks = qs + 128; LAS float* red = ks + 128;
    const int bh = blockIdx.x, b = bh >> 3, h = bh & 7, c = F.tid & 127, wv = (F.tid >> 6) & 1; const bool act = F.tid < 128;
    float S[128];
#pragma unroll
    for (int k = 0; k < 128; ++k) S[k] = 0.f;
    float wq[4], wk[4], wvv[4];
#pragma unroll
    for (int j = 0; j < 4; ++j) { wq[j] = conv_w[j * 3072 + h * 128 + c]; wk[j] = conv_w[j * 3072 + 1024 + h * 128 + c]; wvv[j] = conv_w[j * 3072 + 2048 + h * 128 + c]; }
    float hq0 = 0.f, hq1 = 0.f, hq2 = 0.f, hk0 = 0.f, hk1 = 0.f, hk2 = 0.f, hv0 = 0.f, hv1 = 0.f, hv2 = 0.f;
    const float dg = dn_g[c];
    for (int t = 0; t < T; ++t) {
        const size_t row = (size_t)b * T + t;
        float yq = 0.f, yk = 0.f, yv = 0.f, o = 0.f;
        if (act) {
            const float xq = bf2f(qkv[row * 3072 + h * 128 + c]), xk = bf2f(qkv[row * 3072 + 1024 + h * 128 + c]), xv = bf2f(qkv[row * 3072 + 2048 + h * 128 + c]);
            yq = wq[0] * hq0 + wq[1] * hq1 + wq[2] * hq2 + wq[3] * xq;
            yk = wk[0] * hk0 + wk[1] * hk1 + wk[2] * hk2 + wk[3] * xk;
            yv = wvv[0] * hv0 + wvv[1] * hv1 + wvv[2] * hv2 + wvv[3] * xv;
            hq0 = hq1; hq1 = hq2; hq2 = xq; hk0 = hk1; hk1 = hk2; hk2 = xk; hv0 = hv1; hv1 = hv2; hv2 = xv;
            yq = yq / (1.0f + expf(-yq)); yk = yk / (1.0f + expf(-yk)); yv = yv / (1.0f + expf(-yv));
            float sq = yq * yq, sk = yk * yk;
#pragma unroll
            for (int of = 1; of < 64; of <<= 1) { sq += __shfl_xor(sq, of); sk += __shfl_xor(sk, of); }
            if ((c & 63) == 0) { red[wv * 2] = sq; red[wv * 2 + 1] = sk; }
        }
        __syncthreads();
        if (act) {
            const float tq = red[0] + red[2], tk = red[1] + red[3];
            qs[c] = yq * (1.0f / sqrtf(tq + L2_EPS)) * 0.08838834764831845f; ks[c] = yk * (1.0f / sqrtf(tk + L2_EPS));
        }
        __syncthreads();
        if (act) {
            const float bt = beta[row * 8 + h], a = expf(gl[row * 8 + h]);
            float kS = 0.f;
#pragma unroll
            for (int kb = 0; kb < 128; kb += 16) { asm volatile("" ::: "memory");
#pragma unroll
                for (int k = kb; k < kb + 16; ++k) kS += ks[k] * S[k]; }
            const float coef = bt * (yv - a * kS);
#pragma unroll
            for (int kb = 0; kb < 128; kb += 16) { asm volatile("" ::: "memory");
#pragma unroll
                for (int k = kb; k < kb + 16; ++k) { S[k] = a * S[k] + ks[k] * coef; o += qs[k] * S[k]; } }
            float so = o * o;
#pragma unroll
            for (int of = 1; of < 64; of <<= 1) so += __shfl_xor(so, of);
            if ((c & 63) == 0) red[4 + wv] = so;
        }
        __syncthreads();
        if (act) {
            const float to = red[4] + red[5];
            onorm[row * 1024 + h * 128 + c] = (bf16)f2bf(o * (1.0f / sqrtf(to * (1.0f / 128.0f) + RMS_EPS)) * dg);
        }
        __syncthreads();
    }
}

struct Args { const float* in[20]; float* out; unsigned char* ws; int ph_lo, ph_hi; };
constexpr int N_PHASES = 17;
__global__ void __launch_bounds__(NWAVES * 64, 2) mk_fwd(Args args) {
    extern __shared__ __attribute__((aligned(16))) unsigned char lds[];
    Frame F;
    F.lds = (LAS unsigned char*)lds;
    F.tid = threadIdx.x; F.lane = F.tid & 63; F.wave = __builtin_amdgcn_readfirstlane(F.tid >> 6);
    F.G = gridDim.x; { const int bx = blockIdx.x; F.vcu = (F.G % 8 == 0) ? (bx % 8) * (F.G / 8) + bx / 8 : bx; }
#pragma unroll
    for (int i = 0; i < 20; ++i) F.in[i] = args.in[i];
    F.out = args.out; F.ws = args.ws;
    unsigned char* ws = args.ws;
    F.MISC = (volatile LAS unsigned*)(F.lds + MISC_OFF); F.ctl = (gu32*)(ws + WS_CTL);
    for (int u = F.tid; u < (LDS_BYTES - LDSCTL_OFF) / 4; u += NWAVES * 64) ((LAS unsigned*)(F.lds + LDSCTL_OFF))[u] = 0u;
    __syncthreads();
    const bool one = (args.ph_hi - args.ph_lo) > 1;
    XcdBarrier bar; bar.bar = (unsigned*)(F.ctl + CW_BAR); bar.x = 0; bar.st = nullptr;
    if (one) bar = xcd_barrier_post((unsigned*)(F.ctl + CW_BAR), F.MISC + 8);
#define SEAM(k) do { if (IN(k) && IN((k) + 1)) xcd_barrier(bar); } while (0)
    const int lo = args.ph_lo, hi = args.ph_hi;
#define IN(k) (lo <= (k) && (k) < hi)
    bf16* Hb = (bf16*)(ws + WS_H);
    const float* mod = (const float*)(ws + WS_MOD);

    if (IN(0)) p0_prologue(F);
    SEAM(0);
    if (IN(1)) {
        LAS float* scr = (LAS float*)(F.lds + RING_OFF + F.wave * 16384);
        const int gw = F.vcu * NWAVES + F.wave, NGW = F.G * NWAVES;
        for (int it = gw; it < (512 / 64) * (D / 32); it += NGW) { const int kb = it / 32, cb = it % 32; tr_item((const float*)(ws + WS_WPP32), D, 64 * kb, 32 * cb, (bf16*)(ws + WS_WPP), 512, 32 * cb, 0, scr, F.lane); }
        normmod_rows(F, F.in[0], Hb, F.in[4] + 0 * D, 0);
    }
    SEAM(1);
    if (IN(2)) { pg8::Gemm g{Hb, (const bf16*)(ws + WS_W1IN), M, NFF_IN, D}; pg8::StaticOrder S; S.init(M, NFF_IN, F.G, (int)blockIdx.x);
        pg8::EpiSwiglu E{(bf16*)(ws + WS_HID), FF};
        pg8::gemm_phase<pg8::EpiSwiglu, pg8::StaticOrder, PG8_ALIGN, PG8_SP2>(F.lds + RING_OFF, g, S, E); }
    SEAM(2);
    if (IN(3)) { pg8::Gemm g{(const bf16*)(ws + WS_HID), (const bf16*)(ws + WS_W1OUT), M, D, FF}; pg8::StaticOrder S; S.init(M, D, F.G, (int)blockIdx.x);
        pg8::EpiResGate E{F.in[0], F.out, D, mod + 0 * 3 * D + 2 * D, NMOD, 0.5f};
        pg8::gemm_phase<pg8::EpiResGate, pg8::StaticOrder, PG8_ALIGN, PG8_SP2>(F.lds + RING_OFF, g, S, E); }
    SEAM(3);
    if (IN(4)) normmod_rows(F, F.out, Hb, F.in[4] + 1 * D, 1);
    SEAM(4);
    if (IN(5)) { pg8::Gemm g{Hb, (const bf16*)(ws + WS_WM1), M, NM1, D}; pg8::StaticOrder S; S.init(M, NM1, F.G, (int)blockIdx.x);
        pg8::EpiM1 E{(bf16*)(ws + WS_QKV), (bf16*)(ws + WS_XP), (float*)(ws + WS_BETA), (float*)(ws + WS_GL), F.in[11], F.in[12]};
        pg8::gemm_phase<pg8::EpiM1, pg8::StaticOrder, PG8_ALIGN, PG8_SP2>(F.lds + RING_OFF, g, S, E); }
    SEAM(5);
    if (IN(6)) pool_phase(F);
    SEAM(6);
    if (IN(7)) dn_naive_phase(F);
    SEAM(7);
    if (IN(8)) { pg8::Gemm g{Hb, (const bf16*)(ws + WS_WG), M, 2048, D}; pg8::StaticOrder S; S.init(M, 2048, F.G, (int)blockIdx.x);
        pg8::EpiSigmoid E{(bf16*)(ws + WS_GATES), 2048};
        pg8::gemm_phase<pg8::EpiSigmoid, pg8::StaticOrder, PG8_ALIGN, PG8_SP2>(F.lds + RING_OFF, g, S, E); }
    SEAM(8);
    if (IN(9)) { pg8::Gemm g{Hb, (const bf16*)(ws + WS_WZ), M, D, D}; pg8::StaticOrder S; S.init(M, D, F.G, (int)blockIdx.x);
        pg8::EpiMulBf16<1> E{(const bf16*)(ws + WS_ONORM), D, (bf16*)(ws + WS_OG), D};
        pg8::gemm_phase<pg8::EpiMulBf16<1>, pg8::StaticOrder, PG8_ALIGN, PG8_SP2>(F.lds + RING_OFF, g, S, E); }
    SEAM(9);
    if (IN(10)) { pg8::Gemm g{(const bf16*)(ws + WS_POOLED), (const bf16*)(ws + WS_WPP), M, D, POOLW}; pg8::StaticOrder S; S.init(M, D, F.G, (int)blockIdx.x);
        pg8::EpiMulBf16<0> E{(const bf16*)(ws + WS_GATES), 2048, (bf16*)(ws + WS_TAB), 2048};
        pg8::gemm_phase<pg8::EpiMulBf16<0>, pg8::StaticOrder, PG8_ALIGN, PG8_SP2>(F.lds + RING_OFF, g, S, E); }
    SEAM(10);
    if (IN(11)) { pg8::Gemm g{(const bf16*)(ws + WS_OG), (const bf16*)(ws + WS_WDN), M, D, D}; pg8::StaticOrder S; S.init(M, D, F.G, (int)blockIdx.x);
        pg8::EpiMulBf16<0> E{(const bf16*)(ws + WS_GATES) + 1024, 2048, (bf16*)(ws + WS_TAB) + 1024, 2048};
        pg8::gemm_phase<pg8::EpiMulBf16<0>, pg8::StaticOrder, PG8_ALIGN, PG8_SP2>(F.lds + RING_OFF, g, S, E); }
    SEAM(11);
    if (IN(12)) { pg8::Gemm g{(const bf16*)(ws + WS_TAB), (const bf16*)(ws + WS_WMO2), M, D, 2 * D}; pg8::StaticOrder S; S.init(M, D, F.G, (int)blockIdx.x);
        pg8::EpiResGate E{F.out, F.out, D, mod + 1 * 3 * D + 2 * D, NMOD, 1.0f};
        pg8::gemm_phase<pg8::EpiResGate, pg8::StaticOrder, PG8_ALIGN, PG8_SP2>(F.lds + RING_OFF, g, S, E); }
    SEAM(12);
    if (IN(13)) normmod_rows(F, F.out, Hb, F.in[4] + 2 * D, 2);
    SEAM(13);
    if (IN(14)) { pg8::Gemm g{Hb, (const bf16*)(ws + WS_W2IN), M, NFF_IN, D}; pg8::StaticOrder S; S.init(M, NFF_IN, F.G, (int)blockIdx.x);
        pg8::EpiSwiglu E{(bf16*)(ws + WS_HID), FF};
        pg8::gemm_phase<pg8::EpiSwiglu, pg8::StaticOrder, PG8_ALIGN, PG8_SP2>(F.lds + RING_OFF, g, S, E); }
    SEAM(14);
    if (IN(15)) { pg8::Gemm g{(const bf16*)(ws + WS_HID), (const bf16*)(ws + WS_W2OUT), M, D, FF}; pg8::StaticOrder S; S.init(M, D, F.G, (int)blockIdx.x);
        pg8::EpiResGate E{F.out, F.out, D, mod + 2 * 3 * D + 2 * D, NMOD, 0.5f};
        pg8::gemm_phase<pg8::EpiResGate, pg8::StaticOrder, PG8_ALIGN, PG8_SP2>(F.lds + RING_OFF, g, S, E); }
    SEAM(15);
    if (IN(16)) final_norm_rows(F, F.out, F.out, F.in[19]);
#undef IN
#undef SEAM
}

extern "C" void kernel_launch(void* const* d_in, const int* in_sizes, int n_in, void* d_out, int out_size, void* d_ws, size_t ws_size, hipStream_t stream) {
    static int grid = 0;
    if (grid == 0) {
        if (n_in != 20 || in_sizes[0] != M * D || out_size != M * D || ws_size < WS_END) { fprintf(stderr, "kernel_launch: unexpected shapes (n_in %d, in0 %d, out %d, ws %zu)\n", n_in, n_in > 0 ? in_sizes[0] : -1, out_size, ws_size); grid = -1; return; }
        int dev = 0, cus = 0;
        if (hipGetDevice(&dev) != hipSuccess || hipDeviceGetAttribute(&cus, hipDeviceAttributeMultiprocessorCount, dev) != hipSuccess) { grid = -1; return; }
        if (hipFuncSetAttribute((const void*)mk_fwd, hipFuncAttributeMaxDynamicSharedMemorySize, LDS_BYTES) != hipSuccess) { fprintf(stderr, "kernel_launch: hipFuncSetAttribute failed\n"); grid = -1; return; }
        int per_cu = 0;
        if (hipOccupancyMaxActiveBlocksPerMultiprocessor(&per_cu, (const void*)mk_fwd, NWAVES * 64, LDS_BYTES) != hipSuccess || per_cu < 1) { fprintf(stderr, "kernel_launch: occupancy query says %d blocks/CU\n", per_cu); }
        (void)hipGetLastError();
        grid = cus;
    }
    if (grid < 0) return;
    if (hipMemsetAsync((char*)d_ws + WS_CTL, 0, CTL_ZERO_BYTES, stream) != hipSuccess) { fprintf(stderr, "kernel_launch: hipMemsetAsync failed\n"); return; }
    Args a{};
    for (int i = 0; i < 20; ++i) a.in[i] = (const float*)d_in[i];
    a.out = (float*)d_out; a.ws = (unsigned char*)d_ws;
    a.ph_lo = 0; a.ph_hi = N_PHASES;
    hipLaunchKernelGGL(mk_fwd, dim3(grid), dim3(NWAVES * 64), LDS_BYTES, stream, a);
}
```

```cpp
#include <hip/hip_runtime.h>
#include <cstdio>
#include <cstdint>
namespace pg8 {
#define PG8_LAS __attribute__((address_space(3)))
typedef unsigned short bf16_t;
typedef short bf16x8 __attribute__((ext_vector_type(8)));
typedef float f32x4 __attribute__((ext_vector_type(4)));
typedef unsigned u32x4 __attribute__((ext_vector_type(4)));
constexpr int BM = 256, BK = 64, HALF = 128, HTB = HALF * BK * 2  , STAGE_BYTES = 8 * HTB, NXCD = 8, WGM = 8;

__host__ __device__ __forceinline__ int lds_byte(int r, int c) { const int st = (r >> 4) * 2 + (c >> 5), rr = r & 15, cc = c & 31, ob = rr * 64 + cc * 2; return st * 1024 + (ob ^ (((ob >> 9) & 1) << 5)); }
__host__ __device__ __forceinline__ void stage_rc(int b, int& R, int& C) { const int st = b / 1024, sb = b % 1024, swz = sb ^ (((sb >> 9) & 1) << 5); R = (st >> 1) * 16 + swz / 64; C = (st & 1) * 32 + (swz % 64) / 2; }
__host__ __device__ __forceinline__ int perm32(int rho) { const int n = rho >> 4, i = rho & 15; return 8 * (i >> 2) + 4 * n + (i & 3); }

struct Unit { int pm, pn; };
struct Gemm { const bf16_t* A; const bf16_t* Bt; int M, N, K; };

struct StaticOrder {
    int nM, nN, nwg, G, c;
    __host__ __device__ void init(int M, int N, int G_, int c_) { nM = M / BM; nN = N / BM; nwg = nM * nN; G = G_; c = c_; }
    __host__ __device__ bool next(int i, Unit& u) const {
        const long L = (long)i * G + c; if (L >= nwg) return false;
        int wgid = (int)L; { const int q = nwg / NXCD, r = nwg % NXCD, xcd = wgid % NXCD, off = wgid / NXCD; wgid = (xcd < r ? xcd * (q + 1) : r * (q + 1) + (xcd - r) * q) + off; }
        const int nig = WGM * nN, gid = wgid / nig, fm = gid * WGM, gsz = (nM - fm) < WGM ? (nM - fm) : WGM;
        u.pm = fm + ((wgid % nig) % gsz); u.pn = (wgid % nig) / gsz; return true;
    }
    __device__ __forceinline__ void a_ready(const Unit&) const {}
    __device__ __forceinline__ void done(const Unit&) const {}
};

typedef float f32x2_t __attribute__((ext_vector_type(2))); typedef __bf16 bf16x2_t __attribute__((ext_vector_type(2)));
__device__ __forceinline__ unsigned cvt_pk_bf16(float lo, float hi) { f32x2_t v = {lo, hi}; bf16x2_t b = __builtin_convertvector(v, bf16x2_t); return __builtin_bit_cast(unsigned, b); }
typedef float f32x2 __attribute__((ext_vector_type(2)));
__device__ __forceinline__ f32x2 gelu_pk(f32x2 v) {
    const f32x2 av = __builtin_elementwise_abs(v), d = av * 0.2316418882f + 1.0f;
    f32x2 t; t.x = __builtin_amdgcn_rcpf(d.x); t.y = __builtin_amdgcn_rcpf(d.y);
    f32x2 q = t * 0.5307027145f + (-0.7265760135f); q = q * t + 0.7107068705f; q = q * t + (-0.142248368f); q = q * t + 0.127414796f; q = q * t;
    const f32x2 s = (v * v) * (-0.72134752044f);
    f32x2 e; e.x = __builtin_amdgcn_exp2f(s.x); e.y = __builtin_amdgcn_exp2f(s.y);
    const f32x2 m = v * (q * e), r = v - m;
    f32x2 o; o.x = v.x < 0.f ? m.x : r.x; o.y = v.y < 0.f ? m.y : r.y; return o;
}

template <int ACT  > struct EpiBf16 {
    static constexpr bool PERM = true, AFTER_DRAIN = false; static_assert(ACT == 0 || ACT == 1, "EpiBf16: ACT is 0 (none) or 1 (gelu_pk)");
    bf16_t* O; int ldc; const float* bias; int split_cols; size_t split_stride; float scale0;
    __device__ __forceinline__ void operator()(const f32x4 (&acc)[2][2][4][2], const Unit& u, int wr, int wc, int fr, int fq) const {
        const int row0 = u.pm * BM + wr * 64 + fr; int colt = u.pn * BM; bf16_t* base = O;
        float sc = 1.f; if (split_cols) { const int t = colt / split_cols; base += (size_t)t * split_stride; colt -= t * split_cols; if (t == 0) sc = scale0; }
        const int col0 = colt + wc * 32 + 8 * fq, bcol0 = u.pn * BM + wc * 32 + 8 * fq;
        f32x4 bv[2][2];
#pragma unroll
        for (int bj = 0; bj < 2; ++bj)
#pragma unroll
            for (int n = 0; n < 2; ++n) bv[bj][n] = bias ? *(const f32x4*)(bias + bcol0 + bj * HALF + 4 * n) : (f32x4){0.f, 0.f, 0.f, 0.f};
#pragma unroll
        for (int ai = 0; ai < 2; ++ai)
#pragma unroll
            for (int m = 0; m < 4; ++m) { bf16_t* rowp = base + (size_t)(row0 + ai * HALF + m * 16) * ldc + col0;
#pragma unroll
                for (int bj = 0; bj < 2; ++bj) { f32x4 v0 = acc[ai][bj][m][0] + bv[bj][0], v1 = acc[ai][bj][m][1] + bv[bj][1];
                    if (ACT == 1) { f32x2 a = gelu_pk((f32x2){v0[0], v0[1]}), b = gelu_pk((f32x2){v0[2], v0[3]}), c = gelu_pk((f32x2){v1[0], v1[1]}), d = gelu_pk((f32x2){v1[2], v1[3]});
                        v0 = (f32x4){a.x, a.y, b.x, b.y}; v1 = (f32x4){c.x, c.y, d.x, d.y}; }
                    v0 = v0 * sc; v1 = v1 * sc; u32x4 w; w.x = cvt_pk_bf16(v0[0], v0[1]); w.y = cvt_pk_bf16(v0[2], v0[3]); w.z = cvt_pk_bf16(v1[0], v1[1]); w.w = cvt_pk_bf16(v1[2], v1[3]);
                    *(u32x4*)(rowp + bj * HALF) = w; } }
    }
};

struct PanelStats {
    unsigned* xbuf;
    unsigned* cnt;
    unsigned* tmo;
    int ntn; float eps;
    unsigned code;
    __device__ __forceinline__ bool run(const f32x4 (&v)[2][2][4][2], const Unit& u, int wr, int wc, int fr, int fq, PG8_LAS unsigned char* lds, int wid, int lane) const {
        typedef float f32x2v __attribute__((ext_vector_type(2)));
        PG8_LAS f32x2v* P = (PG8_LAS f32x2v*)lds;
        PG8_LAS f32x2v* S = (PG8_LAS f32x2v*)(lds + 8192);
        PG8_LAS unsigned* flag = (PG8_LAS unsigned*)(lds + 8192 + 2048);
#pragma unroll
        for (int ai = 0; ai < 2; ++ai)
#pragma unroll
            for (int m = 0; m < 4; ++m) {
                float s = 0.f;
#pragma unroll
                for (int bj = 0; bj < 2; ++bj)
#pragma unroll
                    for (int n = 0; n < 2; ++n) { const f32x4 x = v[ai][bj][m][n]; s += (x[0] + x[1]) + (x[2] + x[3]); }
                s += __shfl_xor(s, 16); s += __shfl_xor(s, 32);
                const float mw = s * (1.0f / 64.0f); float q = 0.f;
#pragma unroll
                for (int bj = 0; bj < 2; ++bj)
#pragma unroll
                    for (int n = 0; n < 2; ++n) { const f32x4 d = v[ai][bj][m][n] - mw; q += (d[0] * d[0] + d[1] * d[1]) + (d[2] * d[2] + d[3] * d[3]); }
                q += __shfl_xor(q, 16); q += __shfl_xor(q, 32);
                if (fq == 0) P[(ai * HALF + wr * 64 + m * 16 + fr) * 4 + wc] = (f32x2v){mw, q};
            }
        asm volatile("s_waitcnt lgkmcnt(0)" ::: "memory"); __builtin_amdgcn_s_barrier(); asm volatile("" ::: "memory");
#if defined(BROKEN_EXCHANGE_NO_WAIT)
#warning BROKEN CONTROL BUILD: the row-statistics exchange does not wait; results are wrong by design
        if (blockIdx.x >= 64) { const long long t0_ = clock64(); while (clock64() - t0_ < 60000) __builtin_amdgcn_s_sleep(8); }
#endif
        const int row = wid * 32 + (lane & 31);
        if (lane < 32) {
            const f32x2v a = P[row * 4 + 0], b = P[row * 4 + 1], c = P[row * 4 + 2], d = P[row * 4 + 3];
            const float mt = (a.x + b.x + c.x + d.x) * 0.25f;
            const float da = a.x - mt, db = b.x - mt, dc = c.x - mt, dd = d.x - mt;
            const float m2 = (a.y + b.y) + (c.y + d.y) + 64.0f * ((da * da + db * db) + (dc * dc + dd * dd));
            unsigned long long* slot = (unsigned long long*)xbuf + ((size_t)(u.pm * BM + row) * 4 + u.pn);
            __hip_atomic_store(slot, ((unsigned long long)__float_as_uint(m2) << 32) | __float_as_uint(mt), __ATOMIC_RELAXED, __HIP_MEMORY_SCOPE_AGENT);
        }
        asm volatile("s_waitcnt vmcnt(0)" ::: "memory");
        if (lane == 0) __hip_atomic_fetch_add(cnt + 64 * u.pm, 1u, __ATOMIC_RELAXED, __HIP_MEMORY_SCOPE_AGENT);
        if (wid == 0) {
            bool dead = false; const unsigned long long t0 = __builtin_amdgcn_s_memrealtime(); const unsigned want = 8u * (unsigned)ntn;
            for (;;) {
#if defined(BROKEN_EXCHANGE_NO_WAIT)
                break;
#endif
                if ((unsigned)__builtin_amdgcn_readfirstlane(__hip_atomic_load(cnt + 64 * u.pm, __ATOMIC_RELAXED, __HIP_MEMORY_SCOPE_AGENT)) >= want) break;
                if (__builtin_amdgcn_s_memrealtime() - t0 > 2000000ull) {
                    if (lane == 0) { unsigned expect = 0u; __hip_atomic_compare_exchange_strong(tmo + 1, &expect, code | (unsigned)(u.pm & 0xff), __ATOMIC_RELAXED, __ATOMIC_RELAXED, __HIP_MEMORY_SCOPE_AGENT);
                                     __hip_atomic_store(tmo, 1u, __ATOMIC_RELAXED, __HIP_MEMORY_SCOPE_AGENT); }
                    dead = true; break; }
                __builtin_amdgcn_s_sleep(2);
            }
            __builtin_amdgcn_fence(__ATOMIC_ACQUIRE, "agent");
            if (lane == 0) flag[0] = dead ? 1u : 0u;
        }
        asm volatile("s_waitcnt vmcnt(0) lgkmcnt(0)" ::: "memory"); __builtin_amdgcn_s_barrier(); asm volatile("" ::: "memory");
        const bool bad = flag[0] != 0u;
        if (lane < 32) {
            const unsigned long long* slot = (const unsigned long long*)xbuf + (size_t)(u.pm * BM + row) * 4; float mt[4], m2[4]; float ms = 0.f;
#pragma unroll
            for (int t = 0; t < 4; ++t) { if (t < ntn) { const unsigned long long w = __hip_atomic_load(slot + t, __ATOMIC_RELAXED, __HIP_MEMORY_SCOPE_AGENT); mt[t] = __uint_as_float((unsigned)w); m2[t] = __uint_as_float((unsigned)(w >> 32)); } else { mt[t] = 0.f; m2[t] = 0.f; } ms += mt[t]; }
            const float mean = ms / (float)ntn; float q = 0.f;
#pragma unroll
            for (int t = 0; t < 4; ++t) if (t < ntn) { const float dm = mt[t] - mean; q += m2[t] + 256.0f * dm * dm; }
            S[row] = (f32x2v){mean, 1.0f / sqrtf(q / (256.0f * (float)ntn) + eps)};
        }
        asm volatile("s_waitcnt lgkmcnt(0)" ::: "memory"); __builtin_amdgcn_s_barrier(); asm volatile("" ::: "memory");
        return bad;
    }
};
struct EpiLnRes {
    static constexpr bool PERM = false, AFTER_DRAIN = true;
    const float* base; float* out; int ldc; const float* bias; PanelStats st; unsigned poison;
    __device__ __forceinline__ void fused(f32x4 (&acc)[2][2][4][2], const Unit& u, int wr, int wc, int fr, int fq, PG8_LAS unsigned char* lds, int wid, int lane) const {
        typedef float f32x2v __attribute__((ext_vector_type(2)));
        const PG8_LAS f32x2v* S = (const PG8_LAS f32x2v*)(lds + 8192);
        const int col0 = u.pn * BM + wc * 32 + 4 * fq;
#pragma unroll
        for (int bj = 0; bj < 2; ++bj)
#pragma unroll
            for (int n = 0; n < 2; ++n) { const f32x4 bv = bias ? *(const f32x4*)(bias + col0 + bj * HALF + n * 16) : (f32x4){0.f, 0.f, 0.f, 0.f};
#pragma unroll
                for (int ai = 0; ai < 2; ++ai)
#pragma unroll
                    for (int m = 0; m < 4; ++m) acc[ai][bj][m][n] += bv; }
        f32x4 pre[4][2][2];
#pragma unroll
        for (int m = 0; m < 4; ++m) { const size_t off = (size_t)(u.pm * BM + wr * 64 + m * 16 + fr) * ldc + col0;
#pragma unroll
            for (int bj = 0; bj < 2; ++bj)
#pragma unroll
                for (int n = 0; n < 2; ++n) pre[m][bj][n] = *(const f32x4*)(base + off + bj * HALF + n * 16); }
        const bool bad = st.run(acc, u, wr, wc, fr, fq, lds, wid, lane) || poison != 0u;
        const float qnan = __builtin_nanf("");
#pragma unroll
        for (int ai = 0; ai < 2; ++ai)
#pragma unroll
            for (int m = 0; m < 4; ++m) { const int r = ai * HALF + wr * 64 + m * 16 + fr; const f32x2v sr = S[r]; const size_t off = (size_t)(u.pm * BM + r) * ldc + col0;
#pragma unroll
                for (int bj = 0; bj < 2; ++bj)
#pragma unroll
                    for (int n = 0; n < 2; ++n) { const f32x4 bs = ai == 0 ? pre[m][bj][n] : *(const f32x4*)(base + off + bj * HALF + n * 16); f32x4 o = bs + (acc[ai][bj][m][n] - sr.x) * sr.y;
                        if (bad) o = (f32x4){qnan, qnan, qnan, qnan}; *(f32x4*)(out + off + bj * HALF + n * 16) = o; }
                if (m & 1) asm volatile("" ::: "memory"); }
    }
};
struct EpiLnResLn {
    static constexpr bool PERM = false, AFTER_DRAIN = true;
    const float* base; float* out; bf16_t* xn; int ldc; const float* bias; PanelStats st1, st2; unsigned poison;
    __device__ __forceinline__ void fused(f32x4 (&acc)[2][2][4][2], const Unit& u, int wr, int wc, int fr, int fq, PG8_LAS unsigned char* lds, int wid, int lane) const {
        typedef float f32x2v __attribute__((ext_vector_type(2))); typedef unsigned u32x2v __attribute__((ext_vector_type(2)));
        const PG8_LAS f32x2v* S = (const PG8_LAS f32x2v*)(lds + 8192);
        const int col0 = u.pn * BM + wc * 32 + 4 * fq;
#pragma unroll
        for (int bj = 0; bj < 2; ++bj)
#pragma unroll
            for (int n = 0; n < 2; ++n) { const f32x4 bv = bias ? *(const f32x4*)(bias + col0 + bj * HALF + n * 16) : (f32x4){0.f, 0.f, 0.f, 0.f};
#pragma unroll
                for (int ai = 0; ai < 2; ++ai)
#pragma unroll
                    for (int m = 0; m < 4; ++m) acc[ai][bj][m][n] += bv; }
        bool bad = st1.run(acc, u, wr, wc, fr, fq, lds, wid, lane) || poison != 0u;
        const float qnan = __builtin_nanf("");
#pragma unroll
        for (int ai = 0; ai < 2; ++ai)
#pragma unroll
            for (int m = 0; m < 4; ++m) { const int r = ai * HALF + wr * 64 + m * 16 + fr; const f32x2v sr = S[r]; const size_t off = (size_t)(u.pm * BM + r) * ldc + col0;
#pragma unroll
                for (int bj = 0; bj < 2; ++bj)
#pragma unroll
                    for (int n = 0; n < 2; ++n) { const f32x4 bs = *(const f32x4*)(base + off + bj * HALF + n * 16); acc[ai][bj][m][n] = bs + (acc[ai][bj][m][n] - sr.x) * sr.y; }
                asm volatile("" : "+v"(acc[ai][0][m][0]), "+v"(acc[ai][0][m][1]), "+v"(acc[ai][1][m][0]), "+v"(acc[ai][1][m][1]));
                if (m & 1) asm volatile("" ::: "memory"); }
        const bool bad1 = bad;
        bad = st2.run(acc, u, wr, wc, fr, fq, lds, wid, lane) || bad;
#pragma unroll
        for (int ai = 0; ai < 2; ++ai)
#pragma unroll
            for (int m = 0; m < 4; ++m) { const int r = ai * HALF + wr * 64 + m * 16 + fr; const f32x2v sr = S[r]; const size_t off = (size_t)(u.pm * BM + r) * ldc + col0;
#pragma unroll
                for (int bj = 0; bj < 2; ++bj)
#pragma unroll
                    for (int n = 0; n < 2; ++n) { const f32x4 x1 = acc[ai][bj][m][n]; *(f32x4*)(out + off + bj * HALF + n * 16) = bad1 ? (f32x4){qnan, qnan, qnan, qnan} : x1;
                        const f32x4 o = (x1 - sr.x) * sr.y; u32x2v w; w.x = cvt_pk_bf16(o[0], o[1]); w.y = cvt_pk_bf16(o[2], o[3]);
                        if (bad) { w.x = 0x7fc07fc0u; w.y = 0x7fc07fc0u; } *(u32x2v*)(xn + off + bj * HALF + n * 16) = w; }
                asm volatile("" ::: "memory"); }
    }
};

template <class Epi, class Sched, bool ALIGN_EPI = false, bool SP2 = false>
__device__ __forceinline__ void gemm_phase(PG8_LAS unsigned char* lds, const Gemm g, const Sched& S, const Epi& E) {
    const int tid = threadIdx.x, wid = __builtin_amdgcn_readfirstlane(tid >> 6), lane = tid & 63, wr = wid >> 2, wc = wid & 3, fr = lane & 15, fq = lane >> 4;
    const int K = g.K, nt = K / BK;
    unsigned voffA[2], voffB[2];
#pragma unroll
    for (int i = 0; i < 2; ++i) { int R, C; stage_rc(tid * 16 + i * 8192, R, C); const int Rb = Epi::PERM ? ((R & ~31) + perm32(R & 31)) : R;
        voffA[i] = (unsigned)(R * K + C) * 2u; voffB[i] = (unsigned)(Rb * K + C) * 2u; }
    const size_t kstep = (size_t)(BK * 2);
    const size_t hstep = (size_t)HALF * K * 2;
    const size_t tstep = 2 * hstep;
    const unsigned ldsw = (unsigned)wid * 1024u;
    const int aoff = lds_byte(wr * 64 + fr, fq * 8), boff = lds_byte(wc * 32 + fr, fq * 8);
#define PG8_SA(b, h) (((b) * 2 + (h)) * HTB)
#define PG8_SB(b, h) ((4 + (b) * 2 + (h)) * HTB)
#define PG8_STAGE(bufoff, gbase, voff) do { _Pragma("unroll") for (int _i = 0; _i < 2; ++_i) \
        __builtin_amdgcn_global_load_lds((const unsigned*)((const char*)(gbase) + (voff)[_i]), (PG8_LAS unsigned*)(lds + (bufoff) + ldsw + _i * 8192), 16, 0, 0); } while (0)
#define PG8_LDA(dst, b, h) do { _Pragma("unroll") for (int m = 0; m < 4; ++m) _Pragma("unroll") for (int k = 0; k < 2; ++k) dst[m][k] = *(const PG8_LAS bf16x8*)(lds + PG8_SA(b, h) + aoff + m * 2048 + k * 1024); } while (0)
#define PG8_LDB(dst, b, h) do { _Pragma("unroll") for (int n = 0; n < 2; ++n) _Pragma("unroll") for (int k = 0; k < 2; ++k) dst[n][k] = *(const PG8_LAS bf16x8*)(lds + PG8_SB(b, h) + boff + n * 2048 + k * 1024); } while (0)
#define PG8_MMA(ai, bj, At, Bt) do { __builtin_amdgcn_s_setprio(1); _Pragma("unroll") for (int m = 0; m < 4; ++m) _Pragma("unroll") for (int n = 0; n < 2; ++n) _Pragma("unroll") for (int k = 0; k < 2; ++k) \
        acc[ai][bj][m][n] = __builtin_amdgcn_mfma_f32_16x16x32_bf16(Bt[n][k], At[m][k], acc[ai][bj][m][n], 0, 0, 0); __builtin_amdgcn_s_setprio(0); } while (0)
#define PG8_WAIT_V(n) asm volatile("s_waitcnt vmcnt(" #n ")" ::: "memory")
#define PG8_WAIT_L(n) asm volatile("s_waitcnt lgkmcnt(" #n ")" ::: "memory")
#define PG8_BAR __builtin_amdgcn_s_barrier()
#define PG8_SCHED __builtin_amdgcn_sched_barrier(0)
    Unit cur, nxt; int ui = 0;
    if (!S.next(0, cur)) return;
    f32x4 acc[2][2][4][2];
#pragma unroll
    for (int a = 0; a < 2; ++a)
#pragma unroll
        for (int b = 0; b < 2; ++b)
#pragma unroll
            for (int m = 0; m < 4; ++m)
#pragma unroll
                for (int n = 0; n < 2; ++n) acc[a][b][m][n] = (f32x4){0.f, 0.f, 0.f, 0.f};
    bf16x8 At[4][2], B0[2][2], B1[2][2];
    const char* cA = (const char*)g.A + (size_t)cur.pm * tstep; const char* cB = (const char*)g.Bt + (size_t)cur.pn * tstep;
    S.a_ready(cur);
    if constexpr (SP2) {
        PG8_STAGE(PG8_SB(0, 0), cB, voffB); PG8_STAGE(PG8_SB(0, 1), cB + hstep, voffB); PG8_STAGE(PG8_SA(0, 0), cA, voffA); PG8_STAGE(PG8_SA(0, 1), cA + hstep, voffA);
        if (wr == 1) PG8_BAR;
        PG8_WAIT_V(2); PG8_BAR;
        PG8_STAGE(PG8_SB(1, 0), cB + kstep, voffB); PG8_STAGE(PG8_SA(1, 0), cA + kstep, voffA); PG8_STAGE(PG8_SB(1, 1), cB + hstep + kstep, voffB);
        PG8_WAIT_V(6); PG8_BAR;
    } else {
        PG8_STAGE(PG8_SB(0, 0), cB, voffB); PG8_STAGE(PG8_SA(0, 0), cA, voffA); PG8_STAGE(PG8_SB(0, 1), cB + hstep, voffB); PG8_STAGE(PG8_SA(0, 1), cA + hstep, voffA);
        if (wr == 1) PG8_BAR;
        PG8_WAIT_V(4); PG8_BAR;
        PG8_STAGE(PG8_SB(1, 0), cB + kstep, voffB); PG8_STAGE(PG8_SA(1, 0), cA + kstep, voffA); PG8_STAGE(PG8_SB(1, 1), cB + hstep + kstep, voffB);
        PG8_WAIT_V(6); PG8_BAR;
    }
    for (;;) {
        const bool has_next = S.next(ui + 1, nxt);
        const char* nA = has_next ? (const char*)g.A + (size_t)nxt.pm * tstep : cA; const char* nB = has_next ? (const char*)g.Bt + (size_t)nxt.pn * tstep : cB;
        for (int t = 0; t < nt; t += 2) {
            const bool last = (t == nt - 2);
            const char* a1 = cA + (size_t)(t + 1) * kstep;
            const char* a2 = last ? nA : cA + (size_t)(t + 2) * kstep; const char* b2 = last ? nB : cB + (size_t)(t + 2) * kstep;
            const char* a3 = a2 + kstep; const char* b3 = b2 + kstep;
            if (last && has_next) S.a_ready(nxt);
            if constexpr (SP2) {
            PG8_LDB(B0, 0, 0); PG8_LDB(B1, 0, 1); PG8_SCHED; PG8_LDA(At, 0, 0); PG8_STAGE(PG8_SA(1, 1), a1 + hstep, voffA);
            PG8_WAIT_V(8); PG8_WAIT_L(0); PG8_BAR; PG8_MMA(0, 0, At, B0); PG8_MMA(0, 1, At, B1); PG8_BAR; PG8_SCHED;
            PG8_LDA(At, 0, 1); PG8_STAGE(PG8_SB(0, 0), b2, voffB); PG8_STAGE(PG8_SB(0, 1), b2 + hstep, voffB); PG8_STAGE(PG8_SA(0, 0), a2, voffA);
            PG8_WAIT_V(8); PG8_WAIT_L(0); PG8_BAR; PG8_MMA(1, 0, At, B0); PG8_MMA(1, 1, At, B1); PG8_BAR; PG8_SCHED;
            PG8_LDB(B0, 1, 0); PG8_LDB(B1, 1, 1); PG8_SCHED; PG8_LDA(At, 1, 0); PG8_STAGE(PG8_SA(0, 1), a2 + hstep, voffA);
            PG8_WAIT_V(8); PG8_WAIT_L(0); PG8_BAR; PG8_MMA(0, 0, At, B0); PG8_MMA(0, 1, At, B1); PG8_BAR; PG8_SCHED;
            PG8_LDA(At, 1, 1); PG8_STAGE(PG8_SB(1, 0), b3, voffB); PG8_STAGE(PG8_SB(1, 1), b3 + hstep, voffB); PG8_STAGE(PG8_SA(1, 0), a3, voffA);
            PG8_WAIT_V(8); PG8_WAIT_L(0); PG8_BAR; PG8_MMA(1, 0, At, B0); PG8_MMA(1, 1, At, B1); PG8_BAR; PG8_SCHED;
            } else {
            PG8_LDB(B0, 0, 0); PG8_SCHED; PG8_LDA(At, 0, 0); PG8_STAGE(PG8_SA(1, 1), a1 + hstep, voffA);
            PG8_WAIT_L(8); PG8_BAR; PG8_WAIT_L(0); PG8_MMA(0, 0, At, B0); PG8_BAR; PG8_SCHED;
            PG8_LDB(B1, 0, 1); PG8_STAGE(PG8_SB(0, 0), b2, voffB);
            PG8_BAR; PG8_WAIT_L(0); PG8_MMA(0, 1, At, B1); PG8_BAR;
            PG8_LDA(At, 0, 1); PG8_STAGE(PG8_SA(0, 0), a2, voffA);
            PG8_BAR; PG8_WAIT_L(0); PG8_MMA(1, 0, At, B0); PG8_BAR; PG8_SCHED;
            PG8_STAGE(PG8_SB(0, 1), b2 + hstep, voffB);
            PG8_WAIT_V(6); PG8_BAR; PG8_MMA(1, 1, At, B1); PG8_BAR;
            PG8_LDB(B0, 1, 0); PG8_SCHED; PG8_LDA(At, 1, 0); PG8_STAGE(PG8_SA(0, 1), a2 + hstep, voffA);
            PG8_WAIT_L(8); PG8_BAR; PG8_WAIT_L(0); PG8_MMA(0, 0, At, B0); PG8_BAR; PG8_SCHED;
            PG8_LDB(B1, 1, 1); PG8_STAGE(PG8_SB(1, 0), b3, voffB);
            PG8_BAR; PG8_WAIT_L(0); PG8_MMA(0, 1, At, B1); PG8_BAR;
            PG8_LDA(At, 1, 1); PG8_STAGE(PG8_SA(1, 0), a3, voffA);
            PG8_BAR; PG8_WAIT_L(0); PG8_MMA(1, 0, At, B0); PG8_BAR; PG8_SCHED;
            PG8_STAGE(PG8_SB(1, 1), b3 + hstep, voffB);
            PG8_WAIT_V(6); PG8_BAR; PG8_MMA(1, 1, At, B1); PG8_BAR;
            }
        }
        if constexpr (ALIGN_EPI) { if (wr == 0) PG8_BAR; }
        if constexpr (!Epi::AFTER_DRAIN) { E(acc, cur, wr, wc, fr, fq); S.done(cur); }
        if (!has_next) break;
#pragma unroll
        for (int a = 0; a < 2; ++a)
#pragma unroll
            for (int b = 0; b < 2; ++b)
#pragma unroll
                for (int m = 0; m < 4; ++m)
#pragma unroll
                    for (int n = 0; n < 2; ++n) acc[a][b][m][n] = (f32x4){0.f, 0.f, 0.f, 0.f};
        cur = nxt; cA = nA; cB = nB; ++ui;
        if constexpr (ALIGN_EPI) { if (wr == 1) PG8_BAR; }
    }
    PG8_WAIT_V(0);
    if constexpr (!ALIGN_EPI) { if (wr == 0) PG8_BAR; }
    PG8_BAR;
    if constexpr (Epi::AFTER_DRAIN) { E.fused(acc, cur, wr, wc, fr, fq, lds, wid, lane); S.done(cur); }
#undef PG8_SA
#undef PG8_SB
#undef PG8_STAGE
#undef PG8_LDA
#undef PG8_LDB
#undef PG8_MMA
#undef PG8_WAIT_V
#undef PG8_WAIT_L
#undef PG8_BAR
#undef PG8_SCHED
}
}

#ifndef PG8_SP2
#define PG8_SP2 true
#endif
#ifndef PG8_ALIGN
#define PG8_ALIGN true
#endif

constexpr int NWAVES = 8;
constexpr int BATCH = 4, T = 4096, D = 1024, M = BATCH * T;
constexpr int FF = 2816, NFF_IN = 2 * FF;
constexpr int POOLW = 512, DNW = 1024, NH = 8, HD = 128;
constexpr int MIXW = 6672;
constexpr int NM1 = 3840;
constexpr int NMOD = 9216;
constexpr float RMS_EPS = 1e-6f, L2_EPS = 1e-6f;

constexpr size_t MiB = 1u << 20;
constexpr size_t WS_CTL = 0, CTL_ZERO_BYTES = 1 * MiB;
constexpr size_t WS_W1IN = 1 * MiB;
constexpr size_t WS_W1OUT = 12 * MiB;
constexpr size_t WS_W2IN = WS_W1OUT + 5632 * 1024;
constexpr size_t WS_W2OUT = WS_W2IN + 11 * MiB;
constexpr size_t WS_WM1 = WS_W2OUT + 5632 * 1024;
constexpr size_t WS_WZ = WS_WM1 + (size_t)NM1 * 1024 * 2;
constexpr size_t WS_WG = WS_WZ + 2 * MiB;
constexpr size_t WS_WPP = WS_WG + 4 * MiB;
constexpr size_t WS_WDN = WS_WPP + 1 * MiB;
constexpr size_t WS_WMO2 = WS_WDN + 2 * MiB;
constexpr size_t WS_MOD = WS_WMO2 + 4 * MiB;
constexpr size_t WS_BETA = 55 * MiB;
constexpr size_t WS_GL = WS_BETA + MiB / 2;
constexpr size_t WS_H = 56 * MiB;
constexpr size_t WS_BIG = 88 * MiB;
constexpr size_t WS_END = 256 * MiB;
constexpr size_t WS_HID = WS_BIG;
constexpr size_t WS_QKV = WS_BIG;
constexpr size_t WS_XP = WS_QKV + 96 * MiB;
constexpr size_t WS_WPP32 = WS_XP;
constexpr size_t WS_POOLED = WS_W1IN;
constexpr size_t WS_EX = WS_XP;
constexpr size_t WS_HALO = WS_EX + 48 * MiB;
constexpr size_t WS_SSQ = 237 * MiB;
constexpr size_t WS_EGB = 241 * MiB;
constexpr size_t WS_ONORM = WS_EX;
constexpr size_t WS_GATES = WS_BIG;
constexpr size_t WS_OG = WS_GATES + 64 * MiB;
constexpr size_t WS_TAB = WS_ONORM;
static_assert(WS_MOD + 4 * 9216 * 4 <= WS_BETA && WS_GL + MiB / 2 <= WS_H && WS_TAB + 64 * MiB <= WS_END && WS_HID + 88 * MiB <= WS_END && WS_HALO + 256 * 3 * 3072 * 2 <= WS_SSQ && WS_EGB + 8192 <= WS_END, "d_ws map");

constexpr int RING_OFF = 0, RING_BYTES = 131072;
constexpr int LDSCTL_OFF = RING_BYTES, MISC_OFF = LDSCTL_OFF + 320;
constexpr int LDS_BYTES = 147456;

#define GAS __attribute__((address_space(1)))
#define LAS __attribute__((address_space(3)))
typedef unsigned short bf16;
typedef unsigned v4u __attribute__((ext_vector_type(4)));
typedef unsigned v2u __attribute__((ext_vector_type(2)));
typedef float f32x4 __attribute__((ext_vector_type(4)));
#define LDS_WAIT() asm volatile("s_waitcnt lgkmcnt(0)" ::: "memory")
#define VM_WAIT() asm volatile("s_waitcnt vmcnt(0)" ::: "memory")
__device__ __forceinline__ unsigned f2bf(float f) { unsigned u = __builtin_bit_cast(unsigned, f); return (u + 0x7fffu + ((u >> 16) & 1u)) >> 16; }
__device__ __forceinline__ unsigned pk2(float lo, float hi) { return f2bf(lo) | (f2bf(hi) << 16); }
__device__ __forceinline__ float bf2f(unsigned short b) { return __builtin_bit_cast(float, (unsigned)b << 16); }
__device__ __forceinline__ float bflo(unsigned w) { return __builtin_bit_cast(float, w << 16); }
__device__ __forceinline__ float bfhi(unsigned w) { return __builtin_bit_cast(float, w & 0xffff0000u); }
__device__ __forceinline__ float fast_sigmoid(float x) { return __builtin_amdgcn_rcpf(1.0f + __builtin_amdgcn_exp2f(-1.4426950408889634f * x)); }
__device__ __forceinline__ float fast_silu(float x) { return x * fast_sigmoid(x); }
__device__ __forceinline__ float wave_sum(float v) {
#pragma unroll
    for (int o = 1; o < 64; o <<= 1) v += __shfl_xor(v, o);
    return v;
}

typedef GAS unsigned gu32;
typedef GAS unsigned long long gu64;
#define RLX_AGENT __ATOMIC_RELAXED, __HIP_MEMORY_SCOPE_AGENT
#define XB_TMO      128
#define XB_XCNT(j)  (256  + 64 * (j))
#define XB_XSUB(j)  (1280 + 64 * (j))
#define XB_XGEN(j)  (2304 + 64 * (j))
#define XB_TOP      3328
#define XB_TOPGEN   3392
#define XCD_BAR_WORDS 3456
#define XB_SPIN_CAP (1u << 18)

__device__ __forceinline__ unsigned xb_ld(unsigned* p)              { return __hip_atomic_load(p, __ATOMIC_RELAXED, __HIP_MEMORY_SCOPE_AGENT); }
__device__ __forceinline__ unsigned xb_add(unsigned* p, unsigned v) { return __hip_atomic_fetch_add(p, v, __ATOMIC_RELAXED, __HIP_MEMORY_SCOPE_AGENT); }
__device__ __forceinline__ unsigned xb_xcc_id() { return (unsigned)__builtin_amdgcn_s_getreg((3 << 11) | 20) & 0xFu; }
#define XB_SPIN(cond, bar) do { unsigned _sp = 0; while (cond) { __builtin_amdgcn_s_sleep(1); \
    if ((++_sp & 255u) == 0u) { if (xb_ld(&(bar)[XB_TMO])) break; if (_sp > XB_SPIN_CAP) { atomicAdd(&(bar)[XB_TMO], 1u); break; } } } } while (0)

struct XcdBarrier {
    unsigned* bar; unsigned x;
    volatile LAS unsigned* st;
};

__device__ __forceinline__ XcdBarrier xcd_barrier_post(unsigned* bar, volatile LAS unsigned* st) {
    XcdBarrier b; b.bar = bar; b.x = xb_xcc_id(); b.st = st;
    if (threadIdx.x == 0) (void)xb_add(&bar[XB_XCNT(b.x)], 1u);
    return b;
}
__device__ __forceinline__ void xcd_barrier_complete(unsigned* bar, unsigned x, unsigned& nloc, unsigned& nx) {
    const unsigned G = gridDim.x * gridDim.y * gridDim.z;
    unsigned sum, cnt, mine, sp = 0u;
    for (;;) {
        sum = 0u; cnt = 0u; mine = 0u;
#pragma unroll
        for (unsigned j = 0; j < 16; ++j) { const unsigned c = xb_ld(&bar[XB_XCNT(j)]); sum += c; cnt += (c > 0u) ? 1u : 0u; mine = (j == x) ? c : mine; }
        if (sum == G) break;
        __builtin_amdgcn_s_sleep(1);
        if ((++sp & 255u) == 0u) { if (xb_ld(&bar[XB_TMO])) break; if (sp > XB_SPIN_CAP) { atomicAdd(&bar[XB_TMO], 1u); break; } }
    }
    nloc = mine > 0u ? mine : 1u; nx = cnt > 0u ? cnt : 1u;
}

__device__ __forceinline__ void xcd_barrier(const XcdBarrier& b) {
    asm volatile("s_waitcnt vmcnt(0)" ::: "memory");
    __syncthreads();
    if (threadIdx.x == 0) {
        unsigned* bar = b.bar;
        __builtin_amdgcn_s_waitcnt(0);
        unsigned nloc = b.st[0], nx = b.st[1];
        if (nloc == 0u) { xcd_barrier_complete(bar, b.x, nloc, nx); b.st[0] = nloc; b.st[1] = nx; }
        const unsigned old = xb_add(&bar[XB_XSUB(b.x)], 1u);
        const unsigned gen = old / nloc;
        if (old + 1u == (gen + 1u) * nloc) {
            __builtin_amdgcn_fence(__ATOMIC_RELEASE, "agent");
            asm volatile("s_waitcnt vmcnt(0)" ::: "memory");
            const unsigned og = xb_add(&bar[XB_TOP], 1u);
            const unsigned tg = og / nx;
            if (og + 1u == (tg + 1u) * nx) xb_add(&bar[XB_TOPGEN], 1u);
            else XB_SPIN(xb_ld(&bar[XB_TOPGEN]) == tg, bar);
            __builtin_amdgcn_fence(__ATOMIC_ACQUIRE, "agent");
            xb_add(&bar[XB_XGEN(b.x)], 1u);
            asm volatile("s_waitcnt vmcnt(0)" ::: "memory");
        } else {
            XB_SPIN(xb_ld(&bar[XB_XGEN(b.x)]) == gen, bar);
            __builtin_amdgcn_fence(__ATOMIC_ACQUIRE, "agent");
            asm volatile("s_waitcnt vmcnt(0)" ::: "memory");
        }
    }
    __syncthreads();
}

constexpr int CW_TMO = 0, CW_BAR = 4096;
namespace pg8 {
struct EpiSwiglu {
    static constexpr bool PERM = true, AFTER_DRAIN = false;
    bf16_t* O; int ldc;
    __device__ __forceinline__ void operator()(const f32x4 (&acc)[2][2][4][2], const Unit& u, int wr, int wc, int fr, int fq) const {
        const int row0 = u.pm * BM + wr * 64 + fr, col0 = u.pn * HALF + wc * 32 + 8 * fq;
#pragma unroll
        for (int ai = 0; ai < 2; ++ai)
#pragma unroll
            for (int m = 0; m < 4; ++m) {
                bf16_t* rowp = O + (size_t)(row0 + ai * HALF + m * 16) * ldc + col0;
                float h[8];
#pragma unroll
                for (int n = 0; n < 2; ++n)
#pragma unroll
                    for (int j = 0; j < 4; ++j) h[4 * n + j] = fast_silu(acc[ai][0][m][n][j]) * acc[ai][1][m][n][j];
                u32x4 w; w.x = cvt_pk_bf16(h[0], h[1]); w.y = cvt_pk_bf16(h[2], h[3]); w.z = cvt_pk_bf16(h[4], h[5]); w.w = cvt_pk_bf16(h[6], h[7]);
                *(u32x4*)rowp = w;
            }
    }
};
struct EpiResGate {
    static constexpr bool PERM = false, AFTER_DRAIN = false;
    const float* base; float* out; int ldc; const float* gate; int gate_bstride; float coef;
    __device__ __forceinline__ void operator()(const f32x4 (&acc)[2][2][4][2], const Unit& u, int wr, int wc, int fr, int fq) const {
        const int row0 = u.pm * BM + wr * 64 + fr, col0 = u.pn * BM + wc * 32 + 4 * fq;
        const float* gp = gate + (size_t)((u.pm * BM) / 4096) * gate_bstride + col0;
        f32x4 gv[2][2];
#pragma unroll
        for (int bj = 0; bj < 2; ++bj)
#pragma unroll
            for (int n = 0; n < 2; ++n) gv[bj][n] = *(const f32x4*)(gp + bj * HALF + n * 16) * coef;
#pragma unroll
        for (int ai = 0; ai < 2; ++ai)
#pragma unroll
            for (int m = 0; m < 4; ++m) {
                const size_t off = (size_t)(row0 + ai * HALF + m * 16) * ldc + col0;
#pragma unroll
                for (int bj = 0; bj < 2; ++bj)
#pragma unroll
                    for (int n = 0; n < 2; ++n) { const f32x4 bs = *(const f32x4*)(base + off + bj * HALF + n * 16); *(f32x4*)(out + off + bj * HALF + n * 16) = bs + gv[bj][n] * acc[ai][bj][m][n]; }
            }
    }
};
struct EpiM1 {
    static constexpr bool PERM = true, AFTER_DRAIN = false;
    bf16_t* qkv; bf16_t* xp; float* beta; float* gl; const float* a_log; const float* dt_bias; bf16_t* halo;
    __device__ __forceinline__ void operator()(const f32x4 (&acc)[2][2][4][2], const Unit& u, int wr, int wc, int fr, int fq) const {
        const int row0 = u.pm * BM + wr * 64 + fr;
        if (u.pn < 14) {
            bf16_t* base; int ldc, colt;
            if (u.pn < 12) { base = qkv; ldc = 3072; colt = u.pn * BM; } else { base = xp; ldc = 512; colt = (u.pn - 12) * BM; }
            const int col0 = colt + wc * 32 + 8 * fq;
#pragma unroll
            for (int ai = 0; ai < 2; ++ai)
#pragma unroll
                for (int m = 0; m < 4; ++m) { bf16_t* rowp = base + (size_t)(row0 + ai * HALF + m * 16) * ldc + col0;
#pragma unroll
                    for (int bj = 0; bj < 2; ++bj) { const f32x4 v0 = acc[ai][bj][m][0], v1 = acc[ai][bj][m][1];
                        u32x4 w; w.x = cvt_pk_bf16(v0[0], v0[1]); w.y = cvt_pk_bf16(v0[2], v0[3]); w.z = cvt_pk_bf16(v1[0], v1[1]); w.w = cvt_pk_bf16(v1[2], v1[3]);
                        *(u32x4*)(rowp + bj * HALF) = w;
                        if (m == 3 && u.pn < 12 && fr >= 13)
                            *(u32x4*)(halo + ((size_t)((row0 + ai * HALF + 48) >> 6) * 3 + (fr - 13)) * 3072 + col0 + bj * HALF) = w; } }
        } else if (wc == 0 && fq < 2) {
            float al[8], db[8];
#pragma unroll
            for (int h = 0; h < 8; ++h) { al[h] = -expf(a_log[h]); db[h] = dt_bias[h]; }
#pragma unroll
            for (int ai = 0; ai < 2; ++ai)
#pragma unroll
                for (int m = 0; m < 4; ++m) { const size_t r = (size_t)(row0 + ai * HALF + m * 16);
#pragma unroll
                    for (int n = 0; n < 2; ++n) { const f32x4 v = acc[ai][0][m][n]; f32x4 o;
                        if (fq == 0) {
#pragma unroll
                            for (int j = 0; j < 4; ++j) o[j] = 1.0f / (1.0f + expf(-v[j]));
                            *(f32x4*)(beta + r * 8 + 4 * n) = o;
                        } else {
#pragma unroll
                            for (int j = 0; j < 4; ++j) { const float xx = v[j] + db[4 * n + j]; const float sp = xx > 20.f ? xx : log1pf(expf(xx)); o[j] = al[4 * n + j] * sp; }
                            *(f32x4*)(gl + r * 8 + 4 * n) = o;
                        } } }
        }
    }
};
struct EpiSigmoid {
    static constexpr bool PERM = true, AFTER_DRAIN = false;
    bf16_t* O; int ldc;
    __device__ __forceinline__ void operator()(const f32x4 (&acc)[2][2][4][2], const Unit& u, int wr, int wc, int fr, int fq) const {
        const int row0 = u.pm * BM + wr * 64 + fr, col0 = u.pn * BM + wc * 32 + 8 * fq;
#pragma unroll
        for (int ai = 0; ai < 2; ++ai)
#pragma unroll
            for (int m = 0; m < 4; ++m) { bf16_t* rowp = O + (size_t)(row0 + ai * HALF + m * 16) * ldc + col0;
#pragma unroll
                for (int bj = 0; bj < 2; ++bj) { const f32x4 v0 = acc[ai][bj][m][0], v1 = acc[ai][bj][m][1];
                    u32x4 w; w.x = cvt_pk_bf16(fast_sigmoid(v0[0]), fast_sigmoid(v0[1])); w.y = cvt_pk_bf16(fast_sigmoid(v0[2]), fast_sigmoid(v0[3]));
                    w.z = cvt_pk_bf16(fast_sigmoid(v1[0]), fast_sigmoid(v1[1])); w.w = cvt_pk_bf16(fast_sigmoid(v1[2]), fast_sigmoid(v1[3]));
                    *(u32x4*)(rowp + bj * HALF) = w; } }
    }
};
template <int ACT> struct EpiMulBf16 {
    static constexpr bool PERM = true, AFTER_DRAIN = false;
    const bf16_t* F; int ldf; bf16_t* O; int ldc;
    __device__ __forceinline__ void operator()(const f32x4 (&acc)[2][2][4][2], const Unit& u, int wr, int wc, int fr, int fq) const {
        const int row0 = u.pm * BM + wr * 64 + fr, col0 = u.pn * BM + wc * 32 + 8 * fq;
#pragma unroll
        for (int ai = 0; ai < 2; ++ai)
#pragma unroll
            for (int m = 0; m < 4; ++m) { const size_t r = (size_t)(row0 + ai * HALF + m * 16);
#pragma unroll
                for (int bj = 0; bj < 2; ++bj) { const f32x4 v0 = acc[ai][bj][m][0], v1 = acc[ai][bj][m][1];
                    const u32x4 f = *(const u32x4*)(F + r * ldf + col0 + bj * HALF);
                    float a[8] = {v0[0], v0[1], v0[2], v0[3], v1[0], v1[1], v1[2], v1[3]};
                    if (ACT == 1) {
#pragma unroll
                        for (int j = 0; j < 8; ++j) a[j] = fast_silu(a[j]);
                    }
                    u32x4 w; w.x = cvt_pk_bf16(bflo(f.x) * a[0], bfhi(f.x) * a[1]); w.y = cvt_pk_bf16(bflo(f.y) * a[2], bfhi(f.y) * a[3]);
                    w.z = cvt_pk_bf16(bflo(f.z) * a[4], bfhi(f.z) * a[5]); w.w = cvt_pk_bf16(bflo(f.w) * a[6], bfhi(f.w) * a[7]);
                    *(u32x4*)(O + r * ldc + col0 + bj * HALF) = w; } }
    }
};
}

struct Frame {
    LAS unsigned char* lds;
    volatile LAS unsigned* MISC; gu32* ctl;
    int tid, lane, wave, G, vcu;
    const float* in[20]; float* out; unsigned char* ws;
};

__device__ __forceinline__ void tr_item(const float* W, int ld_src, int k0, int c0, bf16* WT, int ld_dst, int r0, int dk0, LAS float* scr, int lane) {
#pragma unroll 8
    for (int i = 0; i < 32; ++i) { const int kk = 2 * i + (lane >> 5); scr[kk * 33 + (lane & 31)] = W[(size_t)(k0 + kk) * ld_src + c0 + (lane & 31)]; }
    LDS_WAIT(); asm volatile("" ::: "memory");
    const int c = lane & 7;
#pragma unroll
    for (int j = 0; j < 4; ++j) { const int n = (lane >> 3) + 8 * j; const LAS float* s = scr + (8 * c) * 33 + n;
        v4u o; o.x = pk2(s[0 * 33], s[1 * 33]); o.y = pk2(s[2 * 33], s[3 * 33]); o.z = pk2(s[4 * 33], s[5 * 33]); o.w = pk2(s[6 * 33], s[7 * 33]);
        *(GAS v4u*)(WT + (size_t)(r0 + n) * ld_dst + dk0 + k0 + 8 * c) = o; }
    LDS_WAIT(); asm volatile("" ::: "memory");
}

__device__ __forceinline__ void p0_prologue(Frame& F) {
    LAS float* scr = (LAS float*)(F.lds + RING_OFF + F.wave * 16384);
    const int gw = F.vcu * NWAVES + F.wave, NGW = F.G * NWAVES;
    unsigned char* ws = F.ws;
    constexpr int I_FIN = (D / 64) * (NFF_IN / 32);
    constexpr int I_FOUT = (FF / 64) * (D / 32);
    constexpr int I_QKV = (D / 64) * (3072 / 32);
    constexpr int I_XP = (D / 64) * (512 / 32);
    constexpr int I_Z = (D / 64) * (1024 / 32);
    constexpr int I_G = (D / 64) * (2048 / 32);
    constexpr int I_SQ = (D / 64) * (D / 32);
    constexpr int NITEMS = 2 * I_FIN + 2 * I_FOUT + I_QKV + I_XP + I_Z + I_G + 3 * I_SQ;
    for (int it = gw; it < NITEMS; it += NGW) {
        int r = it;
        if (r < 2 * I_FIN) { const int which = r / I_FIN; r -= which * I_FIN; const int kb = r / 176, cb = r % 176;
            const int half = cb / 88, c2 = cb % 88, p = c2 / 4, w = c2 % 4;
            tr_item((which ? F.in[7] : F.in[5]), NFF_IN, 64 * kb, 32 * cb, (bf16*)(ws + (which ? WS_W2IN : WS_W1IN)), D, 256 * p + 128 * half + 32 * w, 0, scr, F.lane); continue; }
        r -= 2 * I_FIN;
        if (r < 2 * I_FOUT) { const int which = r / I_FOUT; r -= which * I_FOUT; const int kb = r / 32, cb = r % 32;
            tr_item((which ? F.in[8] : F.in[6]), D, 64 * kb, 32 * cb, (bf16*)(ws + (which ? WS_W2OUT : WS_W1OUT)), FF, 32 * cb, 0, scr, F.lane); continue; }
        r -= 2 * I_FOUT;
        if (r < I_QKV) { const int kb = r / 96, cb = r % 96; tr_item(F.in[9], MIXW, 64 * kb, 512 + 32 * cb, (bf16*)(ws + WS_WM1), D, 32 * cb, 0, scr, F.lane); continue; }
        r -= I_QKV;
        if (r < I_XP) { const int kb = r / 16, cb = r % 16; tr_item(F.in[9], MIXW, 64 * kb, 32 * cb, (bf16*)(ws + WS_WM1), D, 3072 + 32 * cb, 0, scr, F.lane); continue; }
        r -= I_XP;
        if (r < I_Z) { const int kb = r / 32, cb = r % 32; tr_item(F.in[9], MIXW, 64 * kb, 3584 + 32 * cb, (bf16*)(ws + WS_WZ), D, 32 * cb, 0, scr, F.lane); continue; }
        r -= I_Z;
        if (r < I_G) { const int kb = r / 64, cb = r % 64; tr_item(F.in[9], MIXW, 64 * kb, 4624 + 32 * cb, (bf16*)(ws + WS_WG), D, 32 * cb, 0, scr, F.lane); continue; }
        r -= I_G;
        { const int which = r / I_SQ; r -= which * I_SQ; const int kb = r / 32, cb = r % 32;
          if (which == 0) tr_item(F.in[17], D, 64 * kb, 32 * cb, (bf16*)(ws + WS_WDN), D, 32 * cb, 0, scr, F.lane);
          else tr_item(F.in[18], D, 64 * kb, 32 * cb, (bf16*)(ws + WS_WMO2), 2 * D, 32 * cb, (which - 1) * D, scr, F.lane); }
    }
    {
        bf16* wm1 = (bf16*)(ws + WS_WM1);
        for (int it = gw; it < 16 * 16; it += NGW) { const int n = it & 15, k = (it >> 4) * 64 + F.lane; wm1[(size_t)(3584 + n) * D + k] = (bf16)f2bf(F.in[9][(size_t)k * MIXW + 4608 + n]); }
        for (int it = gw; it < 240 * D / 8 / 64; it += NGW) *(GAS v4u*)(wm1 + (size_t)3600 * D + ((size_t)it * 64 + F.lane) * 8) = (v4u){0u, 0u, 0u, 0u};
    }
    {
        const float* pw = F.in[14]; const float* ps = F.in[15]; const float* pp = F.in[16];
        float* wpp32 = (float*)(ws + WS_WPP32);
        for (int it = gw; it < 512 * 16; it += NGW) {
            const int k = it >> 4, g = k >> 7, n = (it & 15) * 64 + F.lane;
            float a = 0.f;
#pragma unroll 8
            for (int d = 0; d < 128; ++d) a += (pw[(size_t)k * 128 + d] * ps[g * 128 + d]) * pp[(size_t)(g * 128 + d) * D + n];
            wpp32[(size_t)k * D + n] = a;
        }
    }
    {
        __syncthreads();
        LAS float* sc = (LAS float*)(F.lds + 65536);
        LAS float* red = (LAS float*)(F.lds);
        for (int e = F.tid; e < 4 * D; e += NWAVES * 64) { const float cv = F.in[1][e]; sc[e] = cv / (1.0f + expf(-cv)); }
        __syncthreads();
        const float* aw = F.in[2]; const float* ab = F.in[3]; float* mod = (float*)(ws + WS_MOD);
        for (int it = F.vcu; it < NMOD / 64; it += F.G) {
            const int n = it * 64 + F.lane; float a0 = 0.f, a1 = 0.f, a2 = 0.f, a3 = 0.f;
#pragma unroll 16
            for (int kk = 0; kk < 128; ++kk) { const int k = F.wave * 128 + kk; const float w = aw[(size_t)k * NMOD + n];
                a0 += sc[k] * w; a1 += sc[D + k] * w; a2 += sc[2 * D + k] * w; a3 += sc[3 * D + k] * w; }
            red[(F.wave * 4 + 0) * 64 + F.lane] = a0; red[(F.wave * 4 + 1) * 64 + F.lane] = a1; red[(F.wave * 4 + 2) * 64 + F.lane] = a2; red[(F.wave * 4 + 3) * 64 + F.lane] = a3;
            __syncthreads();
            if (F.tid < 256) { const int b = F.tid >> 6, l = F.tid & 63; float s = ab[it * 64 + l];
#pragma unroll
                for (int w = 0; w < 8; ++w) s += red[(w * 4 + b) * 64 + l];
                mod[(size_t)b * NMOD + it * 64 + l] = s; }
            __syncthreads();
        }
    }
}

__device__ __forceinline__ void normmod_rows(Frame& F, const float* X, bf16* H, const float* g, int sub) {
    const int gw = F.vcu * NWAVES + F.wave, NGW = F.G * NWAVES;
    const float* mod = (const float*)(F.ws + WS_MOD);
    for (int m = gw; m < M; m += NGW) {
        const GAS f32x4* xr = (const GAS f32x4*)(X + (size_t)m * D) + F.lane;
        f32x4 v[4]; float s = 0.f;
#pragma unroll
        for (int j = 0; j < 4; ++j) { v[j] = xr[64 * j]; s += (v[j].x * v[j].x + v[j].y * v[j].y) + (v[j].z * v[j].z + v[j].w * v[j].w); }
        const float rs = 1.0f / sqrtf(wave_sum(s) * (1.f / D) + RMS_EPS);
        const float* mb = mod + (size_t)(m / T) * NMOD + sub * 3 * D;
        GAS v2u* o8 = (GAS v2u*)(H + (size_t)m * D) + F.lane;
#pragma unroll
        for (int j = 0; j < 4; ++j) { const int col = 4 * (64 * j + F.lane);
            const f32x4 gg = *(const f32x4*)(g + col), sh = *(const f32x4*)(mb + col), sc = *(const f32x4*)(mb + D + col);
            const f32x4 o = (v[j] * rs * gg) * (sc + 1.0f) + sh;
            v2u w; w.x = pk2(o.x, o.y); w.y = pk2(o.z, o.w); o8[64 * j] = w; }
    }
}
__device__ __forceinline__ void final_norm_rows(Frame& F, const float* X, float* O, const float* g) {
    const int gw = F.vcu * NWAVES + F.wave, NGW = F.G * NWAVES;
    for (int m = gw; m < M; m += NGW) {
        const GAS f32x4* xr = (const GAS f32x4*)(X + (size_t)m * D) + F.lane;
        f32x4 v[4]; float s = 0.f;
#pragma unroll
        for (int j = 0; j < 4; ++j) { v[j] = xr[64 * j]; s += (v[j].x * v[j].x + v[j].y * v[j].y) + (v[j].z * v[j].z + v[j].w * v[j].w); }
        const float rs = 1.0f / sqrtf(wave_sum(s) * (1.f / D) + RMS_EPS);
        GAS f32x4* orow = (GAS f32x4*)(O + (size_t)m * D) + F.lane;
#pragma unroll
        for (int j = 0; j < 4; ++j) { const f32x4 gg = *(const f32x4*)(g + 4 * (64 * j + F.lane)); orow[64 * j] = v[j] * rs * gg; }
    }
}
__device__ __forceinline__ void pool_phase(Frame& F) {
    const bf16* xp = (const bf16*)(F.ws + WS_XP); bf16* pooled = (bf16*)(F.ws + WS_POOLED);
    const int gw = F.vcu * NWAVES + F.wave, NGW = F.G * NWAVES;
    const int c0 = F.lane * 8, w = 2 << (F.lane >> 4);
    for (int ch = gw; ch < M / 64; ch += NGW) {
        const int row0 = ch * 64, t0 = row0 % T;
        float sum[8] = {0.f, 0.f, 0.f, 0.f, 0.f, 0.f, 0.f, 0.f};
        for (int s = 15; s >= 1; --s) {
            if (s <= w - 1 && t0 - s >= 0) { const v4u x = *(const GAS v4u*)(xp + (size_t)(row0 - s) * POOLW + c0);
                sum[0] += bflo(x.x); sum[1] += bfhi(x.x); sum[2] += bflo(x.y); sum[3] += bfhi(x.y); sum[4] += bflo(x.z); sum[5] += bfhi(x.z); sum[6] += bflo(x.w); sum[7] += bfhi(x.w); }
        }
        for (int i = 0; i < 64; ++i) {
            const int t = t0 + i; const v4u x = *(const GAS v4u*)(xp + (size_t)(row0 + i) * POOLW + c0);
            float xv[8] = {bflo(x.x), bfhi(x.x), bflo(x.y), bfhi(x.y), bflo(x.z), bfhi(x.z), bflo(x.w), bfhi(x.w)};
            const float inv = 1.0f / (float)((t + 1) < w ? (t + 1) : w);
            float o[8];
#pragma unroll
            for (int j = 0; j < 8; ++j) { sum[j] += xv[j]; o[j] = sum[j] * inv - xv[j]; }
            v4u ov; ov.x = pk2(o[0], o[1]); ov.y = pk2(o[2], o[3]); ov.z = pk2(o[4], o[5]); ov.w = pk2(o[6], o[7]);
            *(GAS v4u*)(pooled + (size_t)(row0 + i) * POOLW + c0) = ov;
            if (t - w + 1 >= 0) { const v4u y = *(const GAS v4u*)(xp + (size_t)(row0 + i - w + 1) * POOLW + c0);
                sum[0] -= bflo(y.x); sum[1] -= bfhi(y.x); sum[2] -= bflo(y.y); sum[3] -= bfhi(y.y); sum[4] -= bflo(y.z); sum[5] -= bfhi(y.z); sum[6] -= bflo(y.w); sum[7] -= bfhi(y.w); }
        }
    }
}

constexpr int DN_EX_UNIT = 24576;
typedef short bf16x8v __attribute__((ext_vector_type(8)));
typedef float f32x4v __attribute__((ext_vector_type(4)));
__device__ __forceinline__ unsigned char* sub_ptr(unsigned char* base, int off) { return base + (size_t)(off >> 8) * 6144 + (off & 255); }
__device__ __forceinline__ bf16x8v pack8(float a0, float a1, float a2, float a3, float a4, float a5, float a6, float a7) {
    v4u w; w.x = pg8::cvt_pk_bf16(a0, a1); w.y = pg8::cvt_pk_bf16(a2, a3); w.z = pg8::cvt_pk_bf16(a4, a5); w.w = pg8::cvt_pk_bf16(a6, a7); return __builtin_bit_cast(bf16x8v, w); }
#define MFMA_BF16(a, b, c) __builtin_amdgcn_mfma_f32_16x16x32_bf16((a), (b), (c), 0, 0, 0)
#define MFMA_F32(a, b, c) __builtin_amdgcn_mfma_f32_16x16x4f32((a), (b), (c), 0, 0, 0)

constexpr int DA_QH = 0, DA_KH = 17408, DA_KT = 34816, DA_VT = 53248, DA_AM = 71680, DA_TM = 88320, DA_TF = 104960, DA_VEC = 121344;

__device__ __forceinline__ void dn_pre_phase(Frame& F) {
    LAS unsigned char* L = F.lds;
    LAS float* AM = (LAS float*)(L + DA_AM); LAS float* TM = (LAS float*)(L + DA_TM);
    LAS float* v_gc = (LAS float*)(L + DA_VEC); LAS float* v_bet = v_gc + 64; LAS float* v_bg = v_gc + 128; LAS float* v_kds = v_gc + 192; LAS float* v_qs = v_gc + 256;
    const int wave = F.wave;
    unsigned char* ws = F.ws;
    const float* conv_w = F.in[10];
#define DN_OPAQUE_LANE() int tid = F.tid; asm volatile("" : "+v"(tid)); const int lane = tid & 63, q = lane >> 4, l15 = lane & 15; (void)q; (void)l15
    for (int unit = F.vcu; unit < 32 * 64; unit += F.G) {
        const int bh = unit >> 6, n = unit & 63, b = bh >> 3, h = bh & 7;
        const size_t row_base = (size_t)b * T + 64 * n;
        unsigned char* qbase = ws + WS_QKV + (row_base * 3072 + h * 128) * 2;
        unsigned char* exu = ws + WS_EX + (size_t)unit * DN_EX_UNIT;
        { DN_OPAQUE_LANE();
        if (tid < 384) {
            const int grp = tid >> 4, cg = tid & 15, rb = grp / 3, tensor = grp - 3 * rb;
            const bf16* src = (const bf16*)(qbase + tensor * 2048) + 8 * cg;
            const bf16* hal = (const bf16*)(ws + WS_HALO) + ((size_t)(b * 64 + n - 1) * 3) * 3072 + tensor * 1024 + h * 128 + 8 * cg;
            v4u xr[11];
#pragma unroll
            for (int k = 0; k < 11; ++k) { const int rr = 8 * rb - 3 + k;
                if (rr >= 0) xr[k] = *(const GAS v4u*)(src + (size_t)rr * 3072);
                else if (n > 0) xr[k] = *(const GAS v4u*)(hal + (size_t)(rr + 3) * 3072);
                else xr[k] = (v4u){0u, 0u, 0u, 0u}; }
            float cw[4][8];
#pragma unroll
            for (int j = 0; j < 4; ++j) { const f32x4 c0 = *(const f32x4*)(conv_w + j * 3072 + tensor * 1024 + h * 128 + 8 * cg), c1 = *(const f32x4*)(conv_w + j * 3072 + tensor * 1024 + h * 128 + 8 * cg + 4);
                cw[j][0] = c0.x; cw[j][1] = c0.y; cw[j][2] = c0.z; cw[j][3] = c0.w; cw[j][4] = c1.x; cw[j][5] = c1.y; cw[j][6] = c1.z; cw[j][7] = c1.w; }
            v4u yp[8];
#pragma unroll
            for (int r = 0; r < 8; ++r) {
                float y[8];
#pragma unroll
                for (int c = 0; c < 8; ++c) {
                    float a = 0.f;
#pragma unroll
                    for (int j = 0; j < 4; ++j) { const unsigned wv = (c >> 1) == 0 ? xr[r + j].x : (c >> 1) == 1 ? xr[r + j].y : (c >> 1) == 2 ? xr[r + j].z : xr[r + j].w;
                        a += cw[j][c] * ((c & 1) ? bfhi(wv) : bflo(wv)); }
                    y[c] = a / (1.0f + __expf(-a));
                }
                float ss = 0.f;
#pragma unroll
                for (int c = 0; c < 8; ++c) ss += y[c] * y[c];
                ss += __shfl_xor(ss, 1); ss += __shfl_xor(ss, 2); ss += __shfl_xor(ss, 4); ss += __shfl_xor(ss, 8);
                const float sc = tensor == 2 ? 1.0f : (1.0f / sqrtf(ss + L2_EPS)) * (tensor == 0 ? 0.08838834764831845f : 1.0f);
                v4u w; w.x = pg8::cvt_pk_bf16(y[0] * sc, y[1] * sc); w.y = pg8::cvt_pk_bf16(y[2] * sc, y[3] * sc); w.z = pg8::cvt_pk_bf16(y[4] * sc, y[5] * sc); w.w = pg8::cvt_pk_bf16(y[6] * sc, y[7] * sc);
                yp[r] = w;
                if (tensor < 2) *(LAS v4u*)(L + (tensor == 0 ? DA_QH : DA_KH) + (8 * rb + r) * 272 + 16 * cg) = w;
            }
            if (tensor >= 1) {
                LAS unsigned char* TT = L + (tensor == 1 ? DA_KT : DA_VT);
#pragma unroll
                for (int c = 0; c < 8; ++c) {
                    unsigned hw[8];
#pragma unroll
                    for (int r = 0; r < 8; ++r) { const unsigned wv = (c >> 1) == 0 ? yp[r].x : (c >> 1) == 1 ? yp[r].y : (c >> 1) == 2 ? yp[r].z : yp[r].w; hw[r] = (c & 1) ? (wv >> 16) : (wv & 0xffffu); }
                    v4u o; o.x = hw[0] | (hw[1] << 16); o.y = hw[2] | (hw[3] << 16); o.z = hw[4] | (hw[5] << 16); o.w = hw[6] | (hw[7] << 16);
                    *(LAS v4u*)(TT + (8 * cg + c) * 144 + 16 * rb) = o;
                }
            }
        } else if (wave == 6) {
            const size_t rr = (row_base + lane) * 8 + h;
            float gv = ((const float*)(ws + WS_GL))[rr]; const float bt = ((const float*)(ws + WS_BETA))[rr];
#pragma unroll
            for (int o = 1; o < 64; o <<= 1) { const float t = __shfl_up(gv, o); if (lane >= o) gv += t; }
            const float g63 = __shfl(gv, 63);
            v_gc[lane] = gv; v_bet[lane] = bt; v_bg[lane] = bt * __expf(gv); v_kds[lane] = __expf(g63 - gv); v_qs[lane] = __expf(gv);
            if (lane == 0) ((float*)(ws + WS_EGB))[unit] = __expf(g63);
        } else {
            for (int e = lane; e < 64 * 65; e += 64) TM[e] = 0.f;
        } }
        __syncthreads();
        { DN_OPAQUE_LANE();
        if (wave < 5) {
#pragma unroll
            for (int tt = 0; tt < 2; ++tt) {
                const int ti = 2 * wave + tt, it = ti >= 6 ? 3 : ti >= 3 ? 2 : ti >= 1 ? 1 : 0, jt = ti - (it * (it + 1)) / 2;
                f32x4v acc = {0.f, 0.f, 0.f, 0.f};
#pragma unroll
                for (int ks = 0; ks < 4; ++ks) { const bf16x8v a = *(const LAS bf16x8v*)(L + DA_KH + (16 * it + l15) * 272 + (32 * ks + 8 * q) * 2), bb = *(const LAS bf16x8v*)(L + DA_KH + (16 * jt + l15) * 272 + (32 * ks + 8 * q) * 2);
                    acc = MFMA_BF16(a, bb, acc); }
                const int j = 16 * jt + l15; const float gj = v_gc[j];
#pragma unroll
                for (int r = 0; r < 4; ++r) { const int i = 16 * it + 4 * q + r; AM[i * 65 + j] = (i > j) ? v_bet[i] * acc[r] * __expf(v_gc[i] - gj) : 0.f; }
            }
        } else {
#pragma unroll
            for (int jb = 0; jb < 2; ++jb) {
                const int it = (wave == 5) ? (jb ? 3 : 0) : (wave == 6) ? (jb ? 3 : 1) : 2, ksp = (wave == 5) ? jb : (wave == 6) ? 0 : jb;
                float o8[8];
#pragma unroll
                for (int hf = 0; hf < 2; ++hf) {
                    const int jt = 2 * ksp + hf;
                    f32x4v acc = {0.f, 0.f, 0.f, 0.f};
                    if (jt <= it) {
#pragma unroll
                        for (int ks = 0; ks < 4; ++ks) { const bf16x8v a = *(const LAS bf16x8v*)(L + DA_KH + (16 * jt + l15) * 272 + (32 * ks + 8 * q) * 2), bb = *(const LAS bf16x8v*)(L + DA_QH + (16 * it + l15) * 272 + (32 * ks + 8 * q) * 2);
                            acc = MFMA_BF16(a, bb, acc); }
                    }
                    const int i = 16 * it + l15; const float gi = v_gc[i];
#pragma unroll
                    for (int r = 0; r < 4; ++r) { const int j = 16 * jt + 4 * q + r; o8[4 * hf + r] = (jt <= it && i >= j) ? acc[r] * __expf(gi - v_gc[j]) : 0.f; }
                }
                *(GAS bf16x8v*)(exu + 16384 + (it * 2 + ksp) * 1024 + lane * 16) = pack8(o8[0], o8[1], o8[2], o8[3], o8[4], o8[5], o8[6], o8[7]);
            }
        } }
        __syncthreads();
        if (wave == 0) {
            DN_OPAQUE_LANE(); const int bb = q, c = l15; float tc[16];
#pragma unroll
            for (int r = 0; r < 16; ++r) { float a = (r == c) ? 1.f : 0.f;
#pragma unroll
                for (int s = 0; s < r; ++s) a -= AM[(16 * bb + r) * 65 + 16 * bb + s] * tc[s];
                tc[r] = a; }
#pragma unroll
            for (int r = 0; r < 16; ++r) TM[(16 * bb + r) * 65 + 16 * bb + c] = tc[r];
        }
        __syncthreads();
#pragma unroll
        for (int lev = 1; lev <= 3; ++lev) {
            if (wave < 4 - lev) {
                DN_OPAQUE_LANE(); const int bc = wave, br = wave + lev;
                f32x4v P = {0.f, 0.f, 0.f, 0.f};
                for (int m = bc; m < br; ++m)
#pragma unroll
                    for (int s = 0; s < 4; ++s) P = MFMA_F32(AM[(16 * br + l15) * 65 + 16 * m + 4 * s + q], TM[(16 * m + 4 * s + q) * 65 + 16 * bc + l15], P);
                f32x4v R = {0.f, 0.f, 0.f, 0.f};
#pragma unroll
                for (int s = 0; s < 4; ++s) R = MFMA_F32(TM[(16 * br + l15) * 65 + 16 * br + 4 * q + s], P[s], R);
#pragma unroll
                for (int r = 0; r < 4; ++r) TM[(16 * br + 4 * q + r) * 65 + 16 * bc + l15] = -R[r];
            }
            __syncthreads();
        }
        {
            DN_OPAQUE_LANE(); const int f = tid >> 6, it = f >> 1, ksp = f & 1, i = 16 * it + l15;
            float a0[8], a1[8];
#pragma unroll
            for (int jj = 0; jj < 8; ++jj) { const int j = 32 * ksp + 8 * q + jj; const float t = TM[i * 65 + j]; a0[jj] = t * v_bg[j]; a1[jj] = t * v_bet[j]; }
            *(LAS bf16x8v*)(L + DA_TF + f * 1024 + lane * 16) = pack8(a0[0], a0[1], a0[2], a0[3], a0[4], a0[5], a0[6], a0[7]);
            *(LAS bf16x8v*)(L + DA_TF + 8192 + f * 1024 + lane * 16) = pack8(a1[0], a1[1], a1[2], a1[3], a1[4], a1[5], a1[6], a1[7]);
        }
        __syncthreads();
        {
            DN_OPAQUE_LANE(); const int it = wave & 3, kp = wave >> 2;
            f32x4v acc[4];
#pragma unroll
            for (int dd = 0; dd < 4; ++dd) { acc[dd] = (f32x4v){0.f, 0.f, 0.f, 0.f};
#pragma unroll
                for (int ksp = 0; ksp < 2; ++ksp) { if (ksp == 1 && it < 2) continue;
                    const bf16x8v a = *(const LAS bf16x8v*)(L + DA_KT + (16 * (4 * kp + dd) + l15) * 144 + (32 * ksp + 8 * q) * 2), bb = *(const LAS bf16x8v*)(L + DA_TF + (it * 2 + ksp) * 1024 + lane * 16);
                    acc[dd] = MFMA_BF16(a, bb, acc[dd]); } }
#pragma unroll
            for (int e = 0; e < 2; ++e)
                *(GAS bf16x8v*)(exu + (it * 4 + 2 * kp + e) * 1024 + lane * 16) = pack8(-acc[2 * e][0], -acc[2 * e][1], -acc[2 * e][2], -acc[2 * e][3], -acc[2 * e + 1][0], -acc[2 * e + 1][1], -acc[2 * e + 1][2], -acc[2 * e + 1][3]);
            const int vt = wave;
            f32x4v au[4];
#pragma unroll
            for (int i2 = 0; i2 < 4; ++i2) { au[i2] = (f32x4v){0.f, 0.f, 0.f, 0.f};
#pragma unroll
                for (int ksp = 0; ksp < 2; ++ksp) { if (ksp == 1 && i2 < 2) continue;
                    const bf16x8v a = *(const LAS bf16x8v*)(L + DA_TF + 8192 + (i2 * 2 + ksp) * 1024 + lane * 16), bb = *(const LAS bf16x8v*)(L + DA_VT + (16 * vt + l15) * 144 + (32 * ksp + 8 * q) * 2);
                    au[i2] = MFMA_BF16(a, bb, au[i2]); } }
            unsigned char* vb = qbase + 4096;
            *(GAS bf16x8v*)sub_ptr(vb, vt * 2048 + lane * 32) = pack8(au[0][0], au[0][1], au[0][2], au[0][3], au[1][0], au[1][1], au[1][2], au[1][3]);
            *(GAS bf16x8v*)sub_ptr(vb, vt * 2048 + lane * 32 + 16) = pack8(au[2][0], au[2][1], au[2][2], au[2][3], au[3][0], au[3][1], au[3][2], au[3][3]);
#pragma unroll
            for (int e = 0; e < 2; ++e) {
                const int f = 2 * wave + e;
                { const int it2 = f >> 2, ks = f & 3, i = 16 * it2 + l15; const float sc = v_qs[i];
                  const v2u p0 = *(const LAS v2u*)(L + DA_QH + i * 272 + (32 * ks + 4 * q) * 2), p1 = *(const LAS v2u*)(L + DA_QH + i * 272 + (32 * ks + 16 + 4 * q) * 2);
                  *(GAS bf16x8v*)sub_ptr(qbase, f * 1024 + lane * 16) = pack8(bflo(p0.x) * sc, bfhi(p0.x) * sc, bflo(p0.y) * sc, bfhi(p0.y) * sc, bflo(p1.x) * sc, bfhi(p1.x) * sc, bflo(p1.y) * sc, bfhi(p1.y) * sc); }
                { const int dt = f >> 1, ksp = f & 1, d = 16 * dt + l15, t0 = 32 * ksp + 4 * q, t1 = t0 + 16;
                  const v2u p0 = *(const LAS v2u*)(L + DA_KT + d * 144 + t0 * 2), p1 = *(const LAS v2u*)(L + DA_KT + d * 144 + t1 * 2);
                  *(GAS bf16x8v*)sub_ptr(qbase + 2048, f * 1024 + lane * 16) = pack8(bflo(p0.x) * v_kds[t0], bfhi(p0.x) * v_kds[t0 + 1], bflo(p0.y) * v_kds[t0 + 2], bfhi(p0.y) * v_kds[t0 + 3],
                                                                                    bflo(p1.x) * v_kds[t1], bfhi(p1.x) * v_kds[t1 + 1], bflo(p1.y) * v_kds[t1 + 2], bfhi(p1.y) * v_kds[t1 + 3]); }
            }
        }
        __syncthreads();
    }
#undef DN_OPAQUE_LANE
}

constexpr int DB_WN = 0, DB_QP = 16384, DB_KD = 32768, DB_QK = 49152, DB_UP = 57344, DB_BUF = 65536, DB_OS = 126976;
__device__ __forceinline__ void dn_scan_phase(Frame& F) {
    LAS unsigned char* L = F.lds;
    const int lane = F.lane, wave = F.wave, q = lane >> 4, l15 = lane & 15;
    if (F.vcu >= 256) return;
    const int bh = F.vcu >> 3, vs = F.vcu & 7, b = bh >> 3, h = bh & 7;
    unsigned char* ws = F.ws;
    f32x4v S[8]; bf16x8v Sb[4];
#pragma unroll
    for (int i = 0; i < 8; ++i) S[i] = (f32x4v){0.f, 0.f, 0.f, 0.f};
#pragma unroll
    for (int i = 0; i < 4; ++i) Sb[i] = (bf16x8v){0, 0, 0, 0, 0, 0, 0, 0};
    for (int n = -1; n < 64; ++n) {
        if (wave != 0) {
            if (n + 1 < 64) {
                const int nn = n + 1;
                unsigned char* qb = ws + WS_QKV + (((size_t)b * T + 64 * nn) * 3072 + h * 128) * 2;
                const unsigned char* exu = ws + WS_EX + (size_t)(bh * 64 + nn) * DN_EX_UNIT;
                LAS unsigned char* buf = L + (nn & 1) * DB_BUF;
#pragma unroll
                for (int e = 0; e < 8; ++e) {
                    const int pc = (wave - 1) * 8 + e;
                    const unsigned char* src; int dst;
                    if (pc < 16) { src = exu + pc * 1024 + lane * 16; dst = DB_WN + pc * 1024; }
                    else if (pc < 32) { src = sub_ptr(qb, (pc - 16) * 1024 + lane * 16); dst = DB_QP + (pc - 16) * 1024; }
                    else if (pc < 48) { src = sub_ptr(qb + 2048, (pc - 32) * 1024 + lane * 16); dst = DB_KD + (pc - 32) * 1024; }
                    else if (pc < 54) { const int k6 = pc - 48, slot = k6 == 0 ? 0 : k6 == 1 ? 2 : k6 + 2; src = exu + 16384 + slot * 1024 + lane * 16; dst = DB_QK + slot * 1024; }
                    else { src = sub_ptr(qb + 4096, (2 * vs + (pc - 54)) * 1024 + lane * 16); dst = DB_UP + (pc - 54) * 1024; }
                    __builtin_amdgcn_global_load_lds((const unsigned*)src, (LAS unsigned*)(buf + dst), 16, 0, 0);
                }
            }
        } else if (n >= 0) {
            const LAS unsigned char* buf = L + (n & 1) * DB_BUF;
            const v4u u0 = *(const LAS v4u*)(buf + DB_UP + lane * 32), u1 = *(const LAS v4u*)(buf + DB_UP + lane * 32 + 16);
            f32x4v vn[4];
            vn[0] = (f32x4v){bflo(u0.x), bfhi(u0.x), bflo(u0.y), bfhi(u0.y)}; vn[1] = (f32x4v){bflo(u0.z), bfhi(u0.z), bflo(u0.w), bfhi(u0.w)};
            vn[2] = (f32x4v){bflo(u1.x), bfhi(u1.x), bflo(u1.y), bfhi(u1.y)}; vn[3] = (f32x4v){bflo(u1.z), bfhi(u1.z), bflo(u1.w), bfhi(u1.w)};
#pragma unroll
            for (int it = 0; it < 4; ++it)
#pragma unroll
                for (int ks = 0; ks < 4; ++ks) vn[it] = MFMA_BF16(*(const LAS bf16x8v*)(buf + DB_WN + (it * 4 + ks) * 1024 + lane * 16), Sb[ks], vn[it]);
            bf16x8v vb[2];
            vb[0] = pack8(vn[0][0], vn[0][1], vn[0][2], vn[0][3], vn[1][0], vn[1][1], vn[1][2], vn[1][3]);
            vb[1] = pack8(vn[2][0], vn[2][1], vn[2][2], vn[2][3], vn[3][0], vn[3][1], vn[3][2], vn[3][3]);
            f32x4v oo[4];
#pragma unroll
            for (int it = 0; it < 4; ++it) { oo[it] = (f32x4v){0.f, 0.f, 0.f, 0.f};
#pragma unroll
                for (int ks = 0; ks < 4; ++ks) oo[it] = MFMA_BF16(*(const LAS bf16x8v*)(buf + DB_QP + (it * 4 + ks) * 1024 + lane * 16), Sb[ks], oo[it]);
#pragma unroll
                for (int ksp = 0; ksp < 2; ++ksp) { if (ksp == 1 && it < 2) continue;
                    oo[it] = MFMA_BF16(*(const LAS bf16x8v*)(buf + DB_QK + (it * 2 + ksp) * 1024 + lane * 16), vb[ksp], oo[it]); } }
            const float eg = ((const float*)(ws + WS_EGB))[bh * 64 + n];
#pragma unroll
            for (int dt = 0; dt < 8; ++dt) { S[dt] = S[dt] * eg;
#pragma unroll
                for (int ksp = 0; ksp < 2; ++ksp) S[dt] = MFMA_BF16(*(const LAS bf16x8v*)(buf + DB_KD + (dt * 2 + ksp) * 1024 + lane * 16), vb[ksp], S[dt]); }
#pragma unroll
            for (int ks = 0; ks < 4; ++ks) Sb[ks] = pack8(S[2 * ks][0], S[2 * ks][1], S[2 * ks][2], S[2 * ks][3], S[2 * ks + 1][0], S[2 * ks + 1][1], S[2 * ks + 1][2], S[2 * ks + 1][3]);
            LAS unsigned short* OS = (LAS unsigned short*)(L + DB_OS);
#pragma unroll
            for (int it = 0; it < 4; ++it)
#pragma unroll
                for (int r = 0; r < 4; ++r) OS[(16 * it + 4 * q + r) * 16 + l15] = (unsigned short)f2bf(oo[it][r]);
            LDS_WAIT(); asm volatile("" ::: "memory");
            const v4u o0 = *(const LAS v4u*)(L + DB_OS + lane * 32), o1 = *(const LAS v4u*)(L + DB_OS + lane * 32 + 16);
            float ss = 0.f;
            { const unsigned ww[8] = {o0.x, o0.y, o0.z, o0.w, o1.x, o1.y, o1.z, o1.w};
#pragma unroll
              for (int k = 0; k < 8; ++k) { const float a = bflo(ww[k]), c = bfhi(ww[k]); ss += a * a + c * c; } }
            unsigned char* vbp = ws + WS_QKV + (((size_t)b * T + 64 * n) * 3072 + h * 128) * 2 + 4096;
            *(GAS v4u*)sub_ptr(vbp, vs * 2048 + lane * 32) = o0; *(GAS v4u*)sub_ptr(vbp, vs * 2048 + lane * 32 + 16) = o1;
            ((float*)(ws + WS_SSQ))[(size_t)(bh * 8 + vs) * T + 64 * n + lane] = ss;
            LDS_WAIT(); asm volatile("" ::: "memory");
        }
        __syncthreads();
    }
}

__device__ __forceinline__ void onorm_phase(Frame& F) {
    unsigned char* ws = F.ws; const float* dn_g = F.in[13]; const float* ssq = (const float*)(ws + WS_SSQ); bf16* onorm = (bf16*)(ws + WS_ONORM);
    const int gt = (F.vcu * NWAVES + F.wave) * 64 + F.lane, NT = F.G * NWAVES * 64;
    for (int item = gt; item < M * 128; item += NT) {
        const int row = item >> 7, cgp = item & 127, h = cgp >> 4, c0 = (cgp & 15) * 8, b = row / T, t = row % T, n = t >> 6, tt = t & 63, vs = c0 >> 4, half = (c0 >> 3) & 1;
        unsigned char* vbp = ws + WS_QKV + (((size_t)b * T + 64 * n) * 3072 + h * 128) * 2 + 4096;
        const v4u o = *(const GAS v4u*)sub_ptr(vbp, vs * 2048 + tt * 32 + half * 16);
        float s = 0.f;
#pragma unroll
        for (int v2 = 0; v2 < 8; ++v2) s += ssq[(size_t)((b * 8 + h) * 8 + v2) * T + t];
        const float rs = 1.0f / sqrtf(s * (1.0f / 128.0f) + RMS_EPS);
        const f32x4 g0 = *(const f32x4*)(dn_g + c0), g1 = *(const f32x4*)(dn_g + c0 + 4);
        v4u w; w.x = pk2(bflo(o.x) * rs * g0.x, bfhi(o.x) * rs * g0.y); w.y = pk2(bflo(o.y) * rs * g0.z, bfhi(o.y) * rs * g0.w);
        w.z = pk2(bflo(o.z) * rs * g1.x, bfhi(o.z) * rs * g1.y); w.w = pk2(bflo(o.w) * rs * g1.z, bfhi(o.w) * rs * g1.w);
        *(GAS v4u*)(onorm + (size_t)row * 1024 + h * 128 + c0) = w;
    }
}

struct Args { const float* in[20]; float* out; unsigned char* ws; int ph_lo, ph_hi; };
constexpr int N_PHASES = 19;
__global__ void __launch_bounds__(NWAVES * 64, 2) mk_fwd(Args args) {
    extern __shared__ __attribute__((aligned(16))) unsigned char lds[];
    Frame F;
    F.lds = (LAS unsigned char*)lds;
    F.tid = threadIdx.x; F.lane = F.tid & 63; F.wave = __builtin_amdgcn_readfirstlane(F.tid >> 6);
    F.G = gridDim.x; { const int bx = blockIdx.x; F.vcu = (F.G % 8 == 0) ? (bx % 8) * (F.G / 8) + bx / 8 : bx; }
#pragma unroll
    for (int i = 0; i < 20; ++i) F.in[i] = args.in[i];
    F.out = args.out; F.ws = args.ws;
    unsigned char* ws = args.ws;
    F.MISC = (volatile LAS unsigned*)(F.lds + MISC_OFF); F.ctl = (gu32*)(ws + WS_CTL);
    for (int u = F.tid; u < (LDS_BYTES - LDSCTL_OFF) / 4; u += NWAVES * 64) ((LAS unsigned*)(F.lds + LDSCTL_OFF))[u] = 0u;
    __syncthreads();
    const bool one = (args.ph_hi - args.ph_lo) > 1;
    XcdBarrier bar; bar.bar = (unsigned*)(F.ctl + CW_BAR); bar.x = 0; bar.st = nullptr;
    if (one) bar = xcd_barrier_post((unsigned*)(F.ctl + CW_BAR), F.MISC + 8);
#define SEAM(k) do { if (IN(k) && IN((k) + 1)) xcd_barrier(bar); } while (0)
    const int lo = args.ph_lo, hi = args.ph_hi;
#define IN(k) (lo <= (k) && (k) < hi)
    bf16* Hb = (bf16*)(ws + WS_H);
    const float* mod = (const float*)(ws + WS_MOD);

    if (IN(0)) p0_prologue(F);
    SEAM(0);
    if (IN(1)) {
        LAS float* scr = (LAS float*)(F.lds + RING_OFF + F.wave * 16384);
        const int gw = F.vcu * NWAVES + F.wave, NGW = F.G * NWAVES;
        for (int it = gw; it < (512 / 64) * (D / 32); it += NGW) { const int kb = it / 32, cb = it % 32; tr_item((const float*)(ws + WS_WPP32), D, 64 * kb, 32 * cb, (bf16*)(ws + WS_WPP), 512, 32 * cb, 0, scr, F.lane); }
        normmod_rows(F, F.in[0], Hb, F.in[4] + 0 * D, 0);
    }
    SEAM(1);
    if (IN(2)) { pg8::Gemm g{Hb, (const bf16*)(ws + WS_W1IN), M, NFF_IN, D}; pg8::StaticOrder S; S.init(M, NFF_IN, F.G, (int)blockIdx.x);
        pg8::EpiSwiglu E{(bf16*)(ws + WS_HID), FF};
        pg8::gemm_phase<pg8::EpiSwiglu, pg8::StaticOrder, PG8_ALIGN, PG8_SP2>(F.lds + RING_OFF, g, S, E); }
    SEAM(2);
    if (IN(3)) { pg8::Gemm g{(const bf16*)(ws + WS_HID), (const bf16*)(ws + WS_W1OUT), M, D, FF}; pg8::StaticOrder S; S.init(M, D, F.G, (int)blockIdx.x);
        pg8::EpiResGate E{F.in[0], F.out, D, mod + 0 * 3 * D + 2 * D, NMOD, 0.5f};
        pg8::gemm_phase<pg8::EpiResGate, pg8::StaticOrder, PG8_ALIGN, PG8_SP2>(F.lds + RING_OFF, g, S, E); }
    SEAM(3);
    if (IN(4)) normmod_rows(F, F.out, Hb, F.in[4] + 1 * D, 1);
    SEAM(4);
    if (IN(5)) { pg8::Gemm g{Hb, (const bf16*)(ws + WS_WM1), M, NM1, D}; pg8::StaticOrder S; S.init(M, NM1, F.G, (int)blockIdx.x);
        pg8::EpiM1 E{(bf16*)(ws + WS_QKV), (bf16*)(ws + WS_XP), (float*)(ws + WS_BETA), (float*)(ws + WS_GL), F.in[11], F.in[12], (bf16*)(ws + WS_HALO)};
        pg8::gemm_phase<pg8::EpiM1, pg8::StaticOrder, PG8_ALIGN, PG8_SP2>(F.lds + RING_OFF, g, S, E); }
    SEAM(5);
    if (IN(6)) pool_phase(F);
    SEAM(6);
    if (IN(7)) dn_pre_phase(F);
    SEAM(7);
    if (IN(8)) dn_scan_phase(F);
    SEAM(8);
    if (IN(9)) onorm_phase(F);
    SEAM(9);
    if (IN(10)) { pg8::Gemm g{Hb, (const bf16*)(ws + WS_WG), M, 2048, D}; pg8::StaticOrder S; S.init(M, 2048, F.G, (int)blockIdx.x);
        pg8::EpiSigmoid E{(bf16*)(ws + WS_GATES), 2048};
        pg8::gemm_phase<pg8::EpiSigmoid, pg8::StaticOrder, PG8_ALIGN, PG8_SP2>(F.lds + RING_OFF, g, S, E); }
    SEAM(10);
    if (IN(11)) { pg8::Gemm g{Hb, (const bf16*)(ws + WS_WZ), M, D, D}; pg8::StaticOrder S; S.init(M, D, F.G, (int)blockIdx.x);
        pg8::EpiMulBf16<1> E{(const bf16*)(ws + WS_ONORM), D, (bf16*)(ws + WS_OG), D};
        pg8::gemm_phase<pg8::EpiMulBf16<1>, pg8::StaticOrder, PG8_ALIGN, PG8_SP2>(F.lds + RING_OFF, g, S, E); }
    SEAM(11);
    if (IN(12)) { pg8::Gemm g{(const bf16*)(ws + WS_POOLED), (const bf16*)(ws + WS_WPP), M, D, POOLW}; pg8::StaticOrder S; S.init(M, D, F.G, (int)blockIdx.x);
        pg8::EpiMulBf16<0> E{(const bf16*)(ws + WS_GATES), 2048, (bf16*)(ws + WS_TAB), 2048};
        pg8::gemm_phase<pg8::EpiMulBf16<0>, pg8::StaticOrder, PG8_ALIGN, PG8_SP2>(F.lds + RING_OFF, g, S, E); }
    SEAM(12);
    if (IN(13)) { pg8::Gemm g{(const bf16*)(ws + WS_OG), (const bf16*)(ws + WS_WDN), M, D, D}; pg8::StaticOrder S; S.init(M, D, F.G, (int)blockIdx.x);
        pg8::EpiMulBf16<0> E{(const bf16*)(ws + WS_GATES) + 1024, 2048, (bf16*)(ws + WS_TAB) + 1024, 2048};
        pg8::gemm_phase<pg8::EpiMulBf16<0>, pg8::StaticOrder, PG8_ALIGN, PG8_SP2>(F.lds + RING_OFF, g, S, E); }
    SEAM(13);
    if (IN(14)) { pg8::Gemm g{(const bf16*)(ws + WS_TAB), (const bf16*)(ws + WS_WMO2), M, D, 2 * D}; pg8::StaticOrder S; S.init(M, D, F.G, (int)blockIdx.x);
        pg8::EpiResGate E{F.out, F.out, D, mod + 1 * 3 * D + 2 * D, NMOD, 1.0f};
        pg8::gemm_phase<pg8::EpiResGate, pg8::StaticOrder, PG8_ALIGN, PG8_SP2>(F.lds + RING_OFF, g, S, E); }
    SEAM(14);
    if (IN(15)) normmod_rows(F, F.out, Hb, F.in[4] + 2 * D, 2);
    SEAM(15);
    if (IN(16)) { pg8::Gemm g{Hb, (const bf16*)(ws + WS_W2IN), M, NFF_IN, D}; pg8::StaticOrder S; S.init(M, NFF_IN, F.G, (int)blockIdx.x);
        pg8::EpiSwiglu E{(bf16*)(ws + WS_HID), FF};
        pg8::gemm_phase<pg8::EpiSwiglu, pg8::StaticOrder, PG8_ALIGN, PG8_SP2>(F.lds + RING_OFF, g, S, E); }
    SEAM(16);
    if (IN(17)) { pg8::Gemm g{(const bf16*)(ws + WS_HID), (const bf16*)(ws + WS_W2OUT), M, D, FF}; pg8::StaticOrder S; S.init(M, D, F.G, (int)blockIdx.x);
        pg8::EpiResGate E{F.out, F.out, D, mod + 2 * 3 * D + 2 * D, NMOD, 0.5f};
        pg8::gemm_phase<pg8::EpiResGate, pg8::StaticOrder, PG8_ALIGN, PG8_SP2>(F.lds + RING_OFF, g, S, E); }
    SEAM(17);
    if (IN(18)) final_norm_rows(F, F.out, F.out, F.in[19]);
#undef IN
#undef SEAM
}

extern "C" void kernel_launch(void* const* d_in, const int* in_sizes, int n_in, void* d_out, int out_size, void* d_ws, size_t ws_size, hipStream_t stream) {
    static int grid = 0;
    if (grid == 0) {
        if (n_in != 20 || in_sizes[0] != M * D || out_size != M * D || ws_size < WS_END) { fprintf(stderr, "kernel_launch: unexpected shapes (n_in %d, in0 %d, out %d, ws %zu)\n", n_in, n_in > 0 ? in_sizes[0] : -1, out_size, ws_size); grid = -1; return; }
        int dev = 0, cus = 0;
        if (hipGetDevice(&dev) != hipSuccess || hipDeviceGetAttribute(&cus, hipDeviceAttributeMultiprocessorCount, dev) != hipSuccess) { grid = -1; return; }
        if (hipFuncSetAttribute((const void*)mk_fwd, hipFuncAttributeMaxDynamicSharedMemorySize, LDS_BYTES) != hipSuccess) { fprintf(stderr, "kernel_launch: hipFuncSetAttribute failed\n"); grid = -1; return; }
        int per_cu = 0;
        if (hipOccupancyMaxActiveBlocksPerMultiprocessor(&per_cu, (const void*)mk_fwd, NWAVES * 64, LDS_BYTES) != hipSuccess || per_cu < 1) { fprintf(stderr, "kernel_launch: occupancy query says %d blocks/CU\n", per_cu); }
        (void)hipGetLastError();
        grid = cus;
    }
    if (grid < 0) return;
    if (hipMemsetAsync((char*)d_ws + WS_CTL, 0, CTL_ZERO_BYTES, stream) != hipSuccess) { fprintf(stderr, "kernel_launch: hipMemsetAsync failed\n"); return; }
    Args a{};
    for (int i = 0; i < 20; ++i) a.in[i] = (const float*)d_in[i];
    a.out = (float*)d_out; a.ws = (unsigned char*)d_ws;
    a.ph_lo = 0; a.ph_hi = N_PHASES;
    hipLaunchKernelGGL(mk_fwd, dim3(grid), dim3(NWAVES * 64), LDS_BYTES, stream, a);
}
```

```cpp
#include <hip/hip_runtime.h>
#include <cstdio>
#include <cstdint>
namespace pg8 {
#define PG8_LAS __attribute__((address_space(3)))
typedef unsigned short bf16_t;
typedef short bf16x8 __attribute__((ext_vector_type(8)));
typedef float f32x4 __attribute__((ext_vector_type(4)));
typedef unsigned u32x4 __attribute__((ext_vector_type(4)));
constexpr int BM = 256, BK = 64, HALF = 128, HTB = HALF * BK * 2  , STAGE_BYTES = 8 * HTB, NXCD = 8, WGM = 8;

__host__ __device__ __forceinline__ int lds_byte(int r, int c) { const int st = (r >> 4) * 2 + (c >> 5), rr = r & 15, cc = c & 31, ob = rr * 64 + cc * 2; return st * 1024 + (ob ^ (((ob >> 9) & 1) << 5)); }
__host__ __device__ __forceinline__ void stage_rc(int b, int& R, int& C) { const int st = b / 1024, sb = b % 1024, swz = sb ^ (((sb >> 9) & 1) << 5); R = (st >> 1) * 16 + swz / 64; C = (st & 1) * 32 + (swz % 64) / 2; }
__host__ __device__ __forceinline__ int perm32(int rho) { const int n = rho >> 4, i = rho & 15; return 8 * (i >> 2) + 4 * n + (i & 3); }

struct Unit { int pm, pn; };
struct Gemm { const bf16_t* A; const bf16_t* Bt; int M, N, K; };

struct StaticOrder {
    int nM, nN, nwg, G, c;
    __host__ __device__ void init(int M, int N, int G_, int c_) { nM = M / BM; nN = N / BM; nwg = nM * nN; G = G_; c = c_; }
    __host__ __device__ bool next(int i, Unit& u) const {
        const long L = (long)i * G + c; if (L >= nwg) return false;
        int wgid = (int)L; { const int q = nwg / NXCD, r = nwg % NXCD, xcd = wgid % NXCD, off = wgid / NXCD; wgid = (xcd < r ? xcd * (q + 1) : r * (q + 1) + (xcd - r) * q) + off; }
        const int nig = WGM * nN, gid = wgid / nig, fm = gid * WGM, gsz = (nM - fm) < WGM ? (nM - fm) : WGM;
        u.pm = fm + ((wgid % nig) % gsz); u.pn = (wgid % nig) / gsz; return true;
    }
    __device__ __forceinline__ void a_ready(const Unit&) const {}
    __device__ __forceinline__ void done(const Unit&) const {}
};

typedef float f32x2_t __attribute__((ext_vector_type(2))); typedef __bf16 bf16x2_t __attribute__((ext_vector_type(2)));
__device__ __forceinline__ unsigned cvt_pk_bf16(float lo, float hi) { f32x2_t v = {lo, hi}; bf16x2_t b = __builtin_convertvector(v, bf16x2_t); return __builtin_bit_cast(unsigned, b); }
typedef float f32x2 __attribute__((ext_vector_type(2)));
__device__ __forceinline__ f32x2 gelu_pk(f32x2 v) {
    const f32x2 av = __builtin_elementwise_abs(v), d = av * 0.2316418882f + 1.0f;
    f32x2 t; t.x = __builtin_amdgcn_rcpf(d.x); t.y = __builtin_amdgcn_rcpf(d.y);
    f32x2 q = t * 0.5307027145f + (-0.7265760135f); q = q * t + 0.7107068705f; q = q * t + (-0.142248368f); q = q * t + 0.127414796f; q = q * t;
    const f32x2 s = (v * v) * (-0.72134752044f);
    f32x2 e; e.x = __builtin_amdgcn_exp2f(s.x); e.y = __builtin_amdgcn_exp2f(s.y);
    const f32x2 m = v * (q * e), r = v - m;
    f32x2 o; o.x = v.x < 0.f ? m.x : r.x; o.y = v.y < 0.f ? m.y : r.y; return o;
}

template <int ACT  > struct EpiBf16 {
    static constexpr bool PERM = true, AFTER_DRAIN = false; static_assert(ACT == 0 || ACT == 1, "EpiBf16: ACT is 0 (none) or 1 (gelu_pk)");
    bf16_t* O; int ldc; const float* bias; int split_cols; size_t split_stride; float scale0;
    __device__ __forceinline__ void operator()(const f32x4 (&acc)[2][2][4][2], const Unit& u, int wr, int wc, int fr, int fq) const {
        const int row0 = u.pm * BM + wr * 64 + fr; int colt = u.pn * BM; bf16_t* base = O;
        float sc = 1.f; if (split_cols) { const int t = colt / split_cols; base += (size_t)t * split_stride; colt -= t * split_cols; if (t == 0) sc = scale0; }
        const int col0 = colt + wc * 32 + 8 * fq, bcol0 = u.pn * BM + wc * 32 + 8 * fq;
        f32x4 bv[2][2];
#pragma unroll
        for (int bj = 0; bj < 2; ++bj)
#pragma unroll
            for (int n = 0; n < 2; ++n) bv[bj][n] = bias ? *(const f32x4*)(bias + bcol0 + bj * HALF + 4 * n) : (f32x4){0.f, 0.f, 0.f, 0.f};
#pragma unroll
        for (int ai = 0; ai < 2; ++ai)
#pragma unroll
            for (int m = 0; m < 4; ++m) { bf16_t* rowp = base + (size_t)(row0 + ai * HALF + m * 16) * ldc + col0;
#pragma unroll
                for (int bj = 0; bj < 2; ++bj) { f32x4 v0 = acc[ai][bj][m][0] + bv[bj][0], v1 = acc[ai][bj][m][1] + bv[bj][1];
                    if (ACT == 1) { f32x2 a = gelu_pk((f32x2){v0[0], v0[1]}), b = gelu_pk((f32x2){v0[2], v0[3]}), c = gelu_pk((f32x2){v1[0], v1[1]}), d = gelu_pk((f32x2){v1[2], v1[3]});
                        v0 = (f32x4){a.x, a.y, b.x, b.y}; v1 = (f32x4){c.x, c.y, d.x, d.y}; }
                    v0 = v0 * sc; v1 = v1 * sc; u32x4 w; w.x = cvt_pk_bf16(v0[0], v0[1]); w.y = cvt_pk_bf16(v0[2], v0[3]); w.z = cvt_pk_bf16(v1[0], v1[1]); w.w = cvt_pk_bf16(v1[2], v1[3]);
                    *(u32x4*)(rowp + bj * HALF) = w; } }
    }
};

struct PanelStats {
    unsigned* xbuf;
    unsigned* cnt;
    unsigned* tmo;
    int ntn; float eps;
    unsigned code;
    __device__ __forceinline__ bool run(const f32x4 (&v)[2][2][4][2], const Unit& u, int wr, int wc, int fr, int fq, PG8_LAS unsigned char* lds, int wid, int lane) const {
        typedef float f32x2v __attribute__((ext_vector_type(2)));
        PG8_LAS f32x2v* P = (PG8_LAS f32x2v*)lds;
        PG8_LAS f32x2v* S = (PG8_LAS f32x2v*)(lds + 8192);
        PG8_LAS unsigned* flag = (PG8_LAS unsigned*)(lds + 8192 + 2048);
#pragma unroll
        for (int ai = 0; ai < 2; ++ai)
#pragma unroll
            for (int m = 0; m < 4; ++m) {
                float s = 0.f;
#pragma unroll
                for (int bj = 0; bj < 2; ++bj)
#pragma unroll
                    for (int n = 0; n < 2; ++n) { const f32x4 x = v[ai][bj][m][n]; s += (x[0] + x[1]) + (x[2] + x[3]); }
                s += __shfl_xor(s, 16); s += __shfl_xor(s, 32);
                const float mw = s * (1.0f / 64.0f); float q = 0.f;
#pragma unroll
                for (int bj = 0; bj < 2; ++bj)
#pragma unroll
                    for (int n = 0; n < 2; ++n) { const f32x4 d = v[ai][bj][m][n] - mw; q += (d[0] * d[0] + d[1] * d[1]) + (d[2] * d[2] + d[3] * d[3]); }
                q += __shfl_xor(q, 16); q += __shfl_xor(q, 32);
                if (fq == 0) P[(ai * HALF + wr * 64 + m * 16 + fr) * 4 + wc] = (f32x2v){mw, q};
            }
        asm volatile("s_waitcnt lgkmcnt(0)" ::: "memory"); __builtin_amdgcn_s_barrier(); asm volatile("" ::: "memory");
#if defined(BROKEN_EXCHANGE_NO_WAIT)
#warning BROKEN CONTROL BUILD: the row-statistics exchange does not wait; results are wrong by design
        if (blockIdx.x >= 64) { const long long t0_ = clock64(); while (clock64() - t0_ < 60000) __builtin_amdgcn_s_sleep(8); }
#endif
        const int row = wid * 32 + (lane & 31);
        if (lane < 32) {
            const f32x2v a = P[row * 4 + 0], b = P[row * 4 + 1], c = P[row * 4 + 2], d = P[row * 4 + 3];
            const float mt = (a.x + b.x + c.x + d.x) * 0.25f;
            const float da = a.x - mt, db = b.x - mt, dc = c.x - mt, dd = d.x - mt;
            const float m2 = (a.y + b.y) + (c.y + d.y) + 64.0f * ((da * da + db * db) + (dc * dc + dd * dd));
            unsigned long long* slot = (unsigned long long*)xbuf + ((size_t)(u.pm * BM + row) * 4 + u.pn);
            __hip_atomic_store(slot, ((unsigned long long)__float_as_uint(m2) << 32) | __float_as_uint(mt), __ATOMIC_RELAXED, __HIP_MEMORY_SCOPE_AGENT);
        }
        asm volatile("s_waitcnt vmcnt(0)" ::: "memory");
        if (lane == 0) __hip_atomic_fetch_add(cnt + 64 * u.pm, 1u, __ATOMIC_RELAXED, __HIP_MEMORY_SCOPE_AGENT);
        if (wid == 0) {
            bool dead = false; const unsigned long long t0 = __builtin_amdgcn_s_memrealtime(); const unsigned want = 8u * (unsigned)ntn;
            for (;;) {
#if defined(BROKEN_EXCHANGE_NO_WAIT)
                break;
#endif
                if ((unsigned)__builtin_amdgcn_readfirstlane(__hip_atomic_load(cnt + 64 * u.pm, __ATOMIC_RELAXED, __HIP_MEMORY_SCOPE_AGENT)) >= want) break;
                if (__builtin_amdgcn_s_memrealtime() - t0 > 2000000ull) {
                    if (lane == 0) { unsigned expect = 0u; __hip_atomic_compare_exchange_strong(tmo + 1, &expect, code | (unsigned)(u.pm & 0xff), __ATOMIC_RELAXED, __ATOMIC_RELAXED, __HIP_MEMORY_SCOPE_AGENT);
                                     __hip_atomic_store(tmo, 1u, __ATOMIC_RELAXED, __HIP_MEMORY_SCOPE_AGENT); }
                    dead = true; break; }
                __builtin_amdgcn_s_sleep(2);
            }
            __builtin_amdgcn_fence(__ATOMIC_ACQUIRE, "agent");
            if (lane == 0) flag[0] = dead ? 1u : 0u;
        }
        asm volatile("s_waitcnt vmcnt(0) lgkmcnt(0)" ::: "memory"); __builtin_amdgcn_s_barrier(); asm volatile("" ::: "memory");
        const bool bad = flag[0] != 0u;
        if (lane < 32) {
            const unsigned long long* slot = (const unsigned long long*)xbuf + (size_t)(u.pm * BM + row) * 4; float mt[4], m2[4]; float ms = 0.f;
#pragma unroll
            for (int t = 0; t < 4; ++t) { if (t < ntn) { const unsigned long long w = __hip_atomic_load(slot + t, __ATOMIC_RELAXED, __HIP_MEMORY_SCOPE_AGENT); mt[t] = __uint_as_float((unsigned)w); m2[t] = __uint_as_float((unsigned)(w >> 32)); } else { mt[t] = 0.f; m2[t] = 0.f; } ms += mt[t]; }
            const float mean = ms / (float)ntn; float q = 0.f;
#pragma unroll
            for (int t = 0; t < 4; ++t) if (t < ntn) { const float dm = mt[t] - mean; q += m2[t] + 256.0f * dm * dm; }
            S[row] = (f32x2v){mean, 1.0f / sqrtf(q / (256.0f * (float)ntn) + eps)};
        }
        asm volatile("s_waitcnt lgkmcnt(0)" ::: "memory"); __builtin_amdgcn_s_barrier(); asm volatile("" ::: "memory");
        return bad;
    }
};
struct EpiLnRes {
    static constexpr bool PERM = false, AFTER_DRAIN = true;
    const float* base; float* out; int ldc; const float* bias; PanelStats st; unsigned poison;
    __device__ __forceinline__ void fused(f32x4 (&acc)[2][2][4][2], const Unit& u, int wr, int wc, int fr, int fq, PG8_LAS unsigned char* lds, int wid, int lane) const {
        typedef float f32x2v __attribute__((ext_vector_type(2)));
        const PG8_LAS f32x2v* S = (const PG8_LAS f32x2v*)(lds + 8192);
        const int col0 = u.pn * BM + wc * 32 + 4 * fq;
#pragma unroll
        for (int bj = 0; bj < 2; ++bj)
#pragma unroll
            for (int n = 0; n < 2; ++n) { const f32x4 bv = bias ? *(const f32x4*)(bias + col0 + bj * HALF + n * 16) : (f32x4){0.f, 0.f, 0.f, 0.f};
#pragma unroll
                for (int ai = 0; ai < 2; ++ai)
#pragma unroll
                    for (int m = 0; m < 4; ++m) acc[ai][bj][m][n] += bv; }
        f32x4 pre[4][2][2];
#pragma unroll
        for (int m = 0; m < 4; ++m) { const size_t off = (size_t)(u.pm * BM + wr * 64 + m * 16 + fr) * ldc + col0;
#pragma unroll
            for (int bj = 0; bj < 2; ++bj)
#pragma unroll
                for (int n = 0; n < 2; ++n) pre[m][bj][n] = *(const f32x4*)(base + off + bj * HALF + n * 16); }
        const bool bad = st.run(acc, u, wr, wc, fr, fq, lds, wid, lane) || poison != 0u;
        const float qnan = __builtin_nanf("");
#pragma unroll
        for (int ai = 0; ai < 2; ++ai)
#pragma unroll
            for (int m = 0; m < 4; ++m) { const int r = ai * HALF + wr * 64 + m * 16 + fr; const f32x2v sr = S[r]; const size_t off = (size_t)(u.pm * BM + r) * ldc + col0;
#pragma unroll
                for (int bj = 0; bj < 2; ++bj)
#pragma unroll
                    for (int n = 0; n < 2; ++n) { const f32x4 bs = ai == 0 ? pre[m][bj][n] : *(const f32x4*)(base + off + bj * HALF + n * 16); f32x4 o = bs + (acc[ai][bj][m][n] - sr.x) * sr.y;
                        if (bad) o = (f32x4){qnan, qnan, qnan, qnan}; *(f32x4*)(out + off + bj * HALF + n * 16) = o; }
                if (m & 1) asm volatile("" ::: "memory"); }
    }
};
struct EpiLnResLn {
    static constexpr bool PERM = false, AFTER_DRAIN = true;
    const float* base; float* out; bf16_t* xn; int ldc; const float* bias; PanelStats st1, st2; unsigned poison;
    __device__ __forceinline__ void fused(f32x4 (&acc)[2][2][4][2], const Unit& u, int wr, int wc, int fr, int fq, PG8_LAS unsigned char* lds, int wid, int lane) const {
        typedef float f32x2v __attribute__((ext_vector_type(2))); typedef unsigned u32x2v __attribute__((ext_vector_type(2)));
        const PG8_LAS f32x2v* S = (const PG8_LAS f32x2v*)(lds + 8192);
        const int col0 = u.pn * BM + wc * 32 + 4 * fq;
#pragma unroll
        for (int bj = 0; bj < 2; ++bj)
#pragma unroll
            for (int n = 0; n < 2; ++n) { const f32x4 bv = bias ? *(const f32x4*)(bias + col0 + bj * HALF + n * 16) : (f32x4){0.f, 0.f, 0.f, 0.f};
#pragma unroll
                for (int ai = 0; ai < 2; ++ai)
#pragma unroll
                    for (int m = 0; m < 4; ++m) acc[ai][bj][m][n] += bv; }
        bool bad = st1.run(acc, u, wr, wc, fr, fq, lds, wid, lane) || poison != 0u;
        const float qnan = __builtin_nanf("");
#pragma unroll
        for (int ai = 0; ai < 2; ++ai)
#pragma unroll
            for (int m = 0; m < 4; ++m) { const int r = ai * HALF + wr * 64 + m * 16 + fr; const f32x2v sr = S[r]; const size_t off = (size_t)(u.pm * BM + r) * ldc + col0;
#pragma unroll
                for (int bj = 0; bj < 2; ++bj)
#pragma unroll
                    for (int n = 0; n < 2; ++n) { const f32x4 bs = *(const f32x4*)(base + off + bj * HALF + n * 16); acc[ai][bj][m][n] = bs + (acc[ai][bj][m][n] - sr.x) * sr.y; }
                asm volatile("" : "+v"(acc[ai][0][m][0]), "+v"(acc[ai][0][m][1]), "+v"(acc[ai][1][m][0]), "+v"(acc[ai][1][m][1]));
                if (m & 1) asm volatile("" ::: "memory"); }
        const bool bad1 = bad;
        bad = st2.run(acc, u, wr, wc, fr, fq, lds, wid, lane) || bad;
#pragma unroll
        for (int ai = 0; ai < 2; ++ai)
#pragma unroll
            for (int m = 0; m < 4; ++m) { const int r = ai * HALF + wr * 64 + m * 16 + fr; const f32x2v sr = S[r]; const size_t off = (size_t)(u.pm * BM + r) * ldc + col0;
#pragma unroll
                for (int bj = 0; bj < 2; ++bj)
#pragma unroll
                    for (int n = 0; n < 2; ++n) { const f32x4 x1 = acc[ai][bj][m][n]; *(f32x4*)(out + off + bj * HALF + n * 16) = bad1 ? (f32x4){qnan, qnan, qnan, qnan} : x1;
                        const f32x4 o = (x1 - sr.x) * sr.y; u32x2v w; w.x = cvt_pk_bf16(o[0], o[1]); w.y = cvt_pk_bf16(o[2], o[3]);
                        if (bad) { w.x = 0x7fc07fc0u; w.y = 0x7fc07fc0u; } *(u32x2v*)(xn + off + bj * HALF + n * 16) = w; }
                asm volatile("" ::: "memory"); }
    }
};

template <class Epi, class Sched, bool ALIGN_EPI = false, bool SP2 = false>
__device__ __forceinline__ void gemm_phase(PG8_LAS unsigned char* lds, const Gemm g, const Sched& S, const Epi& E) {
    const int tid = threadIdx.x, wid = __builtin_amdgcn_readfirstlane(tid >> 6), lane = tid & 63, wr = wid >> 2, wc = wid & 3, fr = lane & 15, fq = lane >> 4;
    const int K = g.K, nt = K / BK;
    unsigned voffA[2], voffB[2];
#pragma unroll
    for (int i = 0; i < 2; ++i) { int R, C; stage_rc(tid * 16 + i * 8192, R, C); const int Rb = Epi::PERM ? ((R & ~31) + perm32(R & 31)) : R;
        voffA[i] = (unsigned)(R * K + C) * 2u; voffB[i] = (unsigned)(Rb * K + C) * 2u; }
    const size_t kstep = (size_t)(BK * 2);
    const size_t hstep = (size_t)HALF * K * 2;
    const size_t tstep = 2 * hstep;
    const unsigned ldsw = (unsigned)wid * 1024u;
    const int aoff = lds_byte(wr * 64 + fr, fq * 8), boff = lds_byte(wc * 32 + fr, fq * 8);
#define PG8_SA(b, h) (((b) * 2 + (h)) * HTB)
#define PG8_SB(b, h) ((4 + (b) * 2 + (h)) * HTB)
#define PG8_STAGE(bufoff, gbase, voff) do { _Pragma("unroll") for (int _i = 0; _i < 2; ++_i) \
        __builtin_amdgcn_global_load_lds((const unsigned*)((const char*)(gbase) + (voff)[_i]), (PG8_LAS unsigned*)(lds + (bufoff) + ldsw + _i * 8192), 16, 0, 0); } while (0)
#define PG8_LDA(dst, b, h) do { _Pragma("unroll") for (int m = 0; m < 4; ++m) _Pragma("unroll") for (int k = 0; k < 2; ++k) dst[m][k] = *(const PG8_LAS bf16x8*)(lds + PG8_SA(b, h) + aoff + m * 2048 + k * 1024); } while (0)
#define PG8_LDB(dst, b, h) do { _Pragma("unroll") for (int n = 0; n < 2; ++n) _Pragma("unroll") for (int k = 0; k < 2; ++k) dst[n][k] = *(const PG8_LAS bf16x8*)(lds + PG8_SB(b, h) + boff + n * 2048 + k * 1024); } while (0)
#define PG8_MMA(ai, bj, At, Bt) do { __builtin_amdgcn_s_setprio(1); _Pragma("unroll") for (int m = 0; m < 4; ++m) _Pragma("unroll") for (int n = 0; n < 2; ++n) _Pragma("unroll") for (int k = 0; k < 2; ++k) \
        acc[ai][bj][m][n] = __builtin_amdgcn_mfma_f32_16x16x32_bf16(Bt[n][k], At[m][k], acc[ai][bj][m][n], 0, 0, 0); __builtin_amdgcn_s_setprio(0); } while (0)
#define PG8_WAIT_V(n) asm volatile("s_waitcnt vmcnt(" #n ")" ::: "memory")
#define PG8_WAIT_L(n) asm volatile("s_waitcnt lgkmcnt(" #n ")" ::: "memory")
#define PG8_BAR __builtin_amdgcn_s_barrier()
#define PG8_SCHED __builtin_amdgcn_sched_barrier(0)
    Unit cur, nxt; int ui = 0;
    if (!S.next(0, cur)) return;
    f32x4 acc[2][2][4][2];
#pragma unroll
    for (int a = 0; a < 2; ++a)
#pragma unroll
        for (int b = 0; b < 2; ++b)
#pragma unroll
            for (int m = 0; m < 4; ++m)
#pragma unroll
                for (int n = 0; n < 2; ++n) acc[a][b][m][n] = (f32x4){0.f, 0.f, 0.f, 0.f};
    bf16x8 At[4][2], B0[2][2], B1[2][2];
    const char* cA = (const char*)g.A + (size_t)cur.pm * tstep; const char* cB = (const char*)g.Bt + (size_t)cur.pn * tstep;
    S.a_ready(cur);
    if constexpr (SP2) {
        PG8_STAGE(PG8_SB(0, 0), cB, voffB); PG8_STAGE(PG8_SB(0, 1), cB + hstep, voffB); PG8_STAGE(PG8_SA(0, 0), cA, voffA); PG8_STAGE(PG8_SA(0, 1), cA + hstep, voffA);
        if (wr == 1) PG8_BAR;
        PG8_WAIT_V(2); PG8_BAR;
        PG8_STAGE(PG8_SB(1, 0), cB + kstep, voffB); PG8_STAGE(PG8_SA(1, 0), cA + kstep, voffA); PG8_STAGE(PG8_SB(1, 1), cB + hstep + kstep, voffB);
        PG8_WAIT_V(6); PG8_BAR;
    } else {
        PG8_STAGE(PG8_SB(0, 0), cB, voffB); PG8_STAGE(PG8_SA(0, 0), cA, voffA); PG8_STAGE(PG8_SB(0, 1), cB + hstep, voffB); PG8_STAGE(PG8_SA(0, 1), cA + hstep, voffA);
        if (wr == 1) PG8_BAR;
        PG8_WAIT_V(4); PG8_BAR;
        PG8_STAGE(PG8_SB(1, 0), cB + kstep, voffB); PG8_STAGE(PG8_SA(1, 0), cA + kstep, voffA); PG8_STAGE(PG8_SB(1, 1), cB + hstep + kstep, voffB);
        PG8_WAIT_V(6); PG8_BAR;
    }
    for (;;) {
        const bool has_next = S.next(ui + 1, nxt);
        const char* nA = has_next ? (const char*)g.A + (size_t)nxt.pm * tstep : cA; const char* nB = has_next ? (const char*)g.Bt + (size_t)nxt.pn * tstep : cB;
        for (int t = 0; t < nt; t += 2) {
            const bool last = (t == nt - 2);
            const char* a1 = cA + (size_t)(t + 1) * kstep;
            const char* a2 = last ? nA : cA + (size_t)(t + 2) * kstep; const char* b2 = last ? nB : cB + (size_t)(t + 2) * kstep;
            const char* a3 = a2 + kstep; const char* b3 = b2 + kstep;
            if (last && has_next) S.a_ready(nxt);
            if constexpr (SP2) {
            PG8_LDB(B0, 0, 0); PG8_LDB(B1, 0, 1); PG8_SCHED; PG8_LDA(At, 0, 0); PG8_STAGE(PG8_SA(1, 1), a1 + hstep, voffA);
            PG8_WAIT_V(8); PG8_WAIT_L(0); PG8_BAR; PG8_MMA(0, 0, At, B0); PG8_MMA(0, 1, At, B1); PG8_BAR; PG8_SCHED;
            PG8_LDA(At, 0, 1); PG8_STAGE(PG8_SB(0, 0), b2, voffB); PG8_STAGE(PG8_SB(0, 1), b2 + hstep, voffB); PG8_STAGE(PG8_SA(0, 0), a2, voffA);
            PG8_WAIT_V(8); PG8_WAIT_L(0); PG8_BAR; PG8_MMA(1, 0, At, B0); PG8_MMA(1, 1, At, B1); PG8_BAR; PG8_SCHED;
            PG8_LDB(B0, 1, 0); PG8_LDB(B1, 1, 1); PG8_SCHED; PG8_LDA(At, 1, 0); PG8_STAGE(PG8_SA(0, 1), a2 + hstep, voffA);
            PG8_WAIT_V(8); PG8_WAIT_L(0); PG8_BAR; PG8_MMA(0, 0, At, B0); PG8_MMA(0, 1, At, B1); PG8_BAR; PG8_SCHED;
            PG8_LDA(At, 1, 1); PG8_STAGE(PG8_SB(1, 0), b3, voffB); PG8_STAGE(PG8_SB(1, 1), b3 + hstep, voffB); PG8_STAGE(PG8_SA(1, 0), a3, voffA);
            PG8_WAIT_V(8); PG8_WAIT_L(0); PG8_BAR; PG8_MMA(1, 0, At, B0); PG8_MMA(1, 1, At, B1); PG8_BAR; PG8_SCHED;
            } else {
            PG8_LDB(B0, 0, 0); PG8_SCHED; PG8_LDA(At, 0, 0); PG8_STAGE(PG8_SA(1, 1), a1 + hstep, voffA);
            PG8_WAIT_L(8); PG8_BAR; PG8_WAIT_L(0); PG8_MMA(0, 0, At, B0); PG8_BAR; PG8_SCHED;
            PG8_LDB(B1, 0, 1); PG8_STAGE(PG8_SB(0, 0), b2, voffB);
            PG8_BAR; PG8_WAIT_L(0); PG8_MMA(0, 1, At, B1); PG8_BAR;
            PG8_LDA(At, 0, 1); PG8_STAGE(PG8_SA(0, 0), a2, voffA);
            PG8_BAR; PG8_WAIT_L(0); PG8_MMA(1, 0, At, B0); PG8_BAR; PG8_SCHED;
            PG8_STAGE(PG8_SB(0, 1), b2 + hstep, voffB);
            PG8_WAIT_V(6); PG8_BAR; PG8_MMA(1, 1, At, B1); PG8_BAR;
            PG8_LDB(B0, 1, 0); PG8_SCHED; PG8_LDA(At, 1, 0); PG8_STAGE(PG8_SA(0, 1), a2 + hstep, voffA);
            PG8_WAIT_L(8); PG8_BAR; PG8_WAIT_L(0); PG8_MMA(0, 0, At, B0); PG8_BAR; PG8_SCHED;
            PG8_LDB(B1, 1, 1); PG8_STAGE(PG8_SB(1, 0), b3, voffB);
            PG8_BAR; PG8_WAIT_L(0); PG8_MMA(0, 1, At, B1); PG8_BAR;
            PG8_LDA(At, 1, 1); PG8_STAGE(PG8_SA(1, 0), a3, voffA);
            PG8_BAR; PG8_WAIT_L(0); PG8_MMA(1, 0, At, B0); PG8_BAR; PG8_SCHED;
            PG8_STAGE(PG8_SB(1, 1), b3 + hstep, voffB);
            PG8_WAIT_V(6); PG8_BAR; PG8_MMA(1, 1, At, B1); PG8_BAR;
            }
        }
        if constexpr (ALIGN_EPI) { if (wr == 0) PG8_BAR; }
        if constexpr (!Epi::AFTER_DRAIN) { E(acc, cur, wr, wc, fr, fq); S.done(cur); }
        if (!has_next) break;
#pragma unroll
        for (int a = 0; a < 2; ++a)
#pragma unroll
            for (int b = 0; b < 2; ++b)
#pragma unroll
                for (int m = 0; m < 4; ++m)
#pragma unroll
                    for (int n = 0; n < 2; ++n) acc[a][b][m][n] = (f32x4){0.f, 0.f, 0.f, 0.f};
        cur = nxt; cA = nA; cB = nB; ++ui;
        if constexpr (ALIGN_EPI) { if (wr == 1) PG8_BAR; }
    }
    PG8_WAIT_V(0);
    if constexpr (!ALIGN_EPI) { if (wr == 0) PG8_BAR; }
    PG8_BAR;
    if constexpr (Epi::AFTER_DRAIN) { E.fused(acc, cur, wr, wc, fr, fq, lds, wid, lane); S.done(cur); }
#undef PG8_SA
#undef PG8_SB
#undef PG8_STAGE
#undef PG8_LDA
#undef PG8_LDB
#undef PG8_MMA
#undef PG8_WAIT_V
#undef PG8_WAIT_L
#undef PG8_BAR
#undef PG8_SCHED
}
}

#ifndef PG8_SP2
#define PG8_SP2 true
#endif
#ifndef PG8_ALIGN
#define PG8_ALIGN true
#endif

constexpr int NWAVES = 8;
constexpr int BATCH = 4, T = 4096, D = 1024, M = BATCH * T;
constexpr int FF = 2816, NFF_IN = 2 * FF;
constexpr int POOLW = 512, DNW = 1024, NH = 8, HD = 128;
constexpr int MIXW = 6672;
constexpr int NM1 = 3840;
constexpr int NMOD = 9216;
constexpr float RMS_EPS = 1e-6f, L2_EPS = 1e-6f;

constexpr size_t MiB = 1u << 20;
constexpr size_t WS_CTL = 0, CTL_ZERO_BYTES = 1 * MiB;
constexpr size_t WS_W1IN = 1 * MiB;
constexpr size_t WS_W1OUT = 12 * MiB;
constexpr size_t WS_W2IN = WS_W1OUT + 5632 * 1024;
constexpr size_t WS_W2OUT = WS_W2IN + 11 * MiB;
constexpr size_t WS_WM1 = WS_W2OUT + 5632 * 1024;
constexpr size_t WS_WZ = WS_WM1 + (size_t)NM1 * 1024 * 2;
constexpr size_t WS_WG = WS_WZ + 2 * MiB;
constexpr size_t WS_WPP = WS_WG + 4 * MiB;
constexpr size_t WS_WDN = WS_WPP + 1 * MiB;
constexpr size_t WS_WMO2 = WS_WDN + 2 * MiB;
constexpr size_t WS_MOD = WS_WMO2 + 4 * MiB;
constexpr size_t WS_BETA = 55 * MiB;
constexpr size_t WS_GL = WS_BETA + MiB / 2;
constexpr size_t WS_H = 56 * MiB;
constexpr size_t WS_BIG = 88 * MiB;
constexpr size_t WS_END = 256 * MiB;
constexpr size_t WS_HID = WS_BIG;
constexpr size_t WS_QKV = WS_BIG;
constexpr size_t WS_XP = WS_QKV + 96 * MiB;
constexpr size_t WS_WPP32 = WS_XP;
constexpr size_t WS_POOLED = WS_W1IN;
constexpr size_t WS_EX = WS_XP;
constexpr size_t WS_HALO = WS_EX + 48 * MiB;
constexpr size_t WS_SSQ = 237 * MiB;
constexpr size_t WS_EGB = 241 * MiB;
constexpr size_t WS_ONORM = WS_EX;
constexpr size_t WS_GATES = WS_BIG;
constexpr size_t WS_OG = WS_GATES + 64 * MiB;
constexpr size_t WS_TAB = WS_ONORM;
static_assert(WS_MOD + 4 * 9216 * 4 <= WS_BETA && WS_GL + MiB / 2 <= WS_H && WS_TAB + 64 * MiB <= WS_END && WS_HID + 88 * MiB <= WS_END && WS_HALO + 256 * 3 * 3072 * 2 <= WS_SSQ && WS_EGB + 8192 <= WS_END, "d_ws map");

constexpr int RING_OFF = 0, RING_BYTES = 131072;
constexpr int LDSCTL_OFF = RING_BYTES, MISC_OFF = LDSCTL_OFF + 320;
constexpr int LDS_BYTES = 147456;

#define GAS __attribute__((address_space(1)))
#define LAS __attribute__((address_space(3)))
typedef unsigned short bf16;
typedef unsigned v4u __attribute__((ext_vector_type(4)));
typedef unsigned v2u __attribute__((ext_vector_type(2)));
typedef float f32x4 __attribute__((ext_vector_type(4)));
#define LDS_WAIT() asm volatile("s_waitcnt lgkmcnt(0)" ::: "memory")
#define VM_WAIT() asm volatile("s_waitcnt vmcnt(0)" ::: "memory")
__device__ __forceinline__ unsigned f2bf(float f) { unsigned u = __builtin_bit_cast(unsigned, f); return (u + 0x7fffu + ((u >> 16) & 1u)) >> 16; }
__device__ __forceinline__ unsigned pk2(float lo, float hi) { return f2bf(lo) | (f2bf(hi) << 16); }
__device__ __forceinline__ float bf2f(unsigned short b) { return __builtin_bit_cast(float, (unsigned)b << 16); }
__device__ __forceinline__ float bflo(unsigned w) { return __builtin_bit_cast(float, w << 16); }
__device__ __forceinline__ float bfhi(unsigned w) { return __builtin_bit_cast(float, w & 0xffff0000u); }
__device__ __forceinline__ float fast_sigmoid(float x) { return __builtin_amdgcn_rcpf(1.0f + __builtin_amdgcn_exp2f(-1.4426950408889634f * x)); }
__device__ __forceinline__ float fast_silu(float x) { return x * fast_sigmoid(x); }
__device__ __forceinline__ float wave_sum(float v) {
#pragma unroll
    for (int o = 1; o < 64; o <<= 1) v += __shfl_xor(v, o);
    return v;
}

typedef GAS unsigned gu32;
typedef GAS unsigned long long gu64;
#define RLX_AGENT __ATOMIC_RELAXED, __HIP_MEMORY_SCOPE_AGENT
#define XB_TMO      128
#define XB_XCNT(j)  (256  + 64 * (j))
#define XB_XSUB(j)  (1280 + 64 * (j))
#define XB_XGEN(j)  (2304 + 64 * (j))
#define XB_TOP      3328
#define XB_TOPGEN   3392
#define XCD_BAR_WORDS 3456
#define XB_SPIN_CAP (1u << 18)

__device__ __forceinline__ unsigned xb_ld(unsigned* p)              { return __hip_atomic_load(p, __ATOMIC_RELAXED, __HIP_MEMORY_SCOPE_AGENT); }
__device__ __forceinline__ unsigned xb_add(unsigned* p, unsigned v) { return __hip_atomic_fetch_add(p, v, __ATOMIC_RELAXED, __HIP_MEMORY_SCOPE_AGENT); }
__device__ __forceinline__ unsigned xb_xcc_id() { return (unsigned)__builtin_amdgcn_s_getreg((3 << 11) | 20) & 0xFu; }
#define XB_SPIN(cond, bar) do { unsigned _sp = 0; while (cond) { __builtin_amdgcn_s_sleep(1); \
    if ((++_sp & 255u) == 0u) { if (xb_ld(&(bar)[XB_TMO])) break; if (_sp > XB_SPIN_CAP) { atomicAdd(&(bar)[XB_TMO], 1u); break; } } } } while (0)

struct XcdBarrier {
    unsigned* bar; unsigned x;
    volatile LAS unsigned* st;
};

__device__ __forceinline__ XcdBarrier xcd_barrier_post(unsigned* bar, volatile LAS unsigned* st) {
    XcdBarrier b; b.bar = bar; b.x = xb_xcc_id(); b.st = st;
    if (threadIdx.x == 0) (void)xb_add(&bar[XB_XCNT(b.x)], 1u);
    return b;
}
__device__ __forceinline__ void xcd_barrier_complete(unsigned* bar, unsigned x, unsigned& nloc, unsigned& nx) {
    const unsigned G = gridDim.x * gridDim.y * gridDim.z;
    unsigned sum, cnt, mine, sp = 0u;
    for (;;) {
        sum = 0u; cnt = 0u; mine = 0u;
#pragma unroll
        for (unsigned j = 0; j < 16; ++j) { const unsigned c = xb_ld(&bar[XB_XCNT(j)]); sum += c; cnt += (c > 0u) ? 1u : 0u; mine = (j == x) ? c : mine; }
        if (sum == G) break;
        __builtin_amdgcn_s_sleep(1);
        if ((++sp & 255u) == 0u) { if (xb_ld(&bar[XB_TMO])) break; if (sp > XB_SPIN_CAP) { atomicAdd(&bar[XB_TMO], 1u); break; } }
    }
    nloc = mine > 0u ? mine : 1u; nx = cnt > 0u ? cnt : 1u;
}

__device__ __forceinline__ void xcd_barrier(const XcdBarrier& b) {
    asm volatile("s_waitcnt vmcnt(0)" ::: "memory");
    __syncthreads();
    if (threadIdx.x == 0) {
        unsigned* bar = b.bar;
        __builtin_amdgcn_s_waitcnt(0);
        unsigned nloc = b.st[0], nx = b.st[1];
        if (nloc == 0u) { xcd_barrier_complete(bar, b.x, nloc, nx); b.st[0] = nloc; b.st[1] = nx; }
        const unsigned old = xb_add(&bar[XB_XSUB(b.x)], 1u);
        const unsigned gen = old / nloc;
        if (old + 1u == (gen + 1u) * nloc) {
            __builtin_amdgcn_fence(__ATOMIC_RELEASE, "agent");
            asm volatile("s_waitcnt vmcnt(0)" ::: "memory");
            const unsigned og = xb_add(&bar[XB_TOP], 1u);
            const unsigned tg = og / nx;
            if (og + 1u == (tg + 1u) * nx) xb_add(&bar[XB_TOPGEN], 1u);
            else XB_SPIN(xb_ld(&bar[XB_TOPGEN]) == tg, bar);
            __builtin_amdgcn_fence(__ATOMIC_ACQUIRE, "agent");
            xb_add(&bar[XB_XGEN(b.x)], 1u);
            asm volatile("s_waitcnt vmcnt(0)" ::: "memory");
        } else {
            XB_SPIN(xb_ld(&bar[XB_XGEN(b.x)]) == gen, bar);
            __builtin_amdgcn_fence(__ATOMIC_ACQUIRE, "agent");
            asm volatile("s_waitcnt vmcnt(0)" ::: "memory");
        }
    }
    __syncthreads();
}

constexpr int CW_TMO = 0, CW_BAR = 4096;
namespace pg8 {
struct EpiSwiglu {
    static constexpr bool PERM = true, AFTER_DRAIN = false;
    bf16_t* O; int ldc;
    __device__ __forceinline__ void operator()(const f32x4 (&acc)[2][2][4][2], const Unit& u, int wr, int wc, int fr, int fq) const {
        const int row0 = u.pm * BM + wr * 64 + fr, col0 = u.pn * HALF + wc * 32 + 8 * fq;
#pragma unroll
        for (int ai = 0; ai < 2; ++ai)
#pragma unroll
            for (int m = 0; m < 4; ++m) {
                bf16_t* rowp = O + (size_t)(row0 + ai * HALF + m * 16) * ldc + col0;
                float h[8];
#pragma unroll
                for (int n = 0; n < 2; ++n)
#pragma unroll
                    for (int j = 0; j < 4; ++j) h[4 * n + j] = fast_silu(acc[ai][0][m][n][j]) * acc[ai][1][m][n][j];
                u32x4 w; w.x = cvt_pk_bf16(h[0], h[1]); w.y = cvt_pk_bf16(h[2], h[3]); w.z = cvt_pk_bf16(h[4], h[5]); w.w = cvt_pk_bf16(h[6], h[7]);
                *(u32x4*)rowp = w;
            }
    }
};
struct EpiResGate {
    static constexpr bool PERM = false, AFTER_DRAIN = false;
    const float* base; float* out; int ldc; const float* gate; int gate_bstride; float coef;
    __device__ __forceinline__ void operator()(const f32x4 (&acc)[2][2][4][2], const Unit& u, int wr, int wc, int fr, int fq) const {
        const int row0 = u.pm * BM + wr * 64 + fr, col0 = u.pn * BM + wc * 32 + 4 * fq;
        const float* gp = gate + (size_t)((u.pm * BM) / 4096) * gate_bstride + col0;
        f32x4 gv[2][2];
#pragma unroll
        for (int bj = 0; bj < 2; ++bj)
#pragma unroll
            for (int n = 0; n < 2; ++n) gv[bj][n] = *(const f32x4*)(gp + bj * HALF + n * 16) * coef;
#pragma unroll
        for (int ai = 0; ai < 2; ++ai)
#pragma unroll
            for (int m = 0; m < 4; ++m) {
                const size_t off = (size_t)(row0 + ai * HALF + m * 16) * ldc + col0;
#pragma unroll
                for (int bj = 0; bj < 2; ++bj)
#pragma unroll
                    for (int n = 0; n < 2; ++n) { const f32x4 bs = *(const f32x4*)(base + off + bj * HALF + n * 16); *(f32x4*)(out + off + bj * HALF + n * 16) = bs + gv[bj][n] * acc[ai][bj][m][n]; }
            }
    }
};
struct EpiM1 {
    static constexpr bool PERM = true, AFTER_DRAIN = false;
    bf16_t* qkv; bf16_t* xp; float* beta; float* gl; const float* a_log; const float* dt_bias; bf16_t* halo;
    __device__ __forceinline__ void operator()(const f32x4 (&acc)[2][2][4][2], const Unit& u, int wr, int wc, int fr, int fq) const {
        const int row0 = u.pm * BM + wr * 64 + fr;
        if (u.pn < 14) {
            bf16_t* base; int ldc, colt;
            if (u.pn < 12) { base = qkv; ldc = 3072; colt = u.pn * BM; } else { base = xp; ldc = 512; colt = (u.pn - 12) * BM; }
            const int col0 = colt + wc * 32 + 8 * fq;
#pragma unroll
            for (int ai = 0; ai < 2; ++ai)
#pragma unroll
                for (int m = 0; m < 4; ++m) { bf16_t* rowp = base + (size_t)(row0 + ai * HALF + m * 16) * ldc + col0;
#pragma unroll
                    for (int bj = 0; bj < 2; ++bj) { const f32x4 v0 = acc[ai][bj][m][0], v1 = acc[ai][bj][m][1];
                        u32x4 w; w.x = cvt_pk_bf16(v0[0], v0[1]); w.y = cvt_pk_bf16(v0[2], v0[3]); w.z = cvt_pk_bf16(v1[0], v1[1]); w.w = cvt_pk_bf16(v1[2], v1[3]);
                        *(u32x4*)(rowp + bj * HALF) = w;
                        if (m == 3 && u.pn < 12 && fr >= 13)
                            *(u32x4*)(halo + ((size_t)((row0 + ai * HALF + 48) >> 6) * 3 + (fr - 13)) * 3072 + col0 + bj * HALF) = w; } }
        } else if (wc == 0 && fq < 2) {
            float al[8], db[8];
#pragma unroll
            for (int h = 0; h < 8; ++h) { al[h] = -expf(a_log[h]); db[h] = dt_bias[h]; }
#pragma unroll
            for (int ai = 0; ai < 2; ++ai)
#pragma unroll
                for (int m = 0; m < 4; ++m) { const size_t r = (size_t)(row0 + ai * HALF + m * 16);
#pragma unroll
                    for (int n = 0; n < 2; ++n) { const f32x4 v = acc[ai][0][m][n]; f32x4 o;
                        if (fq == 0) {
#pragma unroll
                            for (int j = 0; j < 4; ++j) o[j] = 1.0f / (1.0f + expf(-v[j]));
                            *(f32x4*)(beta + r * 8 + 4 * n) = o;
                        } else {
#pragma unroll
                            for (int j = 0; j < 4; ++j) { const float xx = v[j] + db[4 * n + j]; const float sp = xx > 20.f ? xx : log1pf(expf(xx)); o[j] = al[4 * n + j] * sp; }
                            *(f32x4*)(gl + r * 8 + 4 * n) = o;
                        } } }
        }
    }
};
struct EpiSigmoid {
    static constexpr bool PERM = true, AFTER_DRAIN = false;
    bf16_t* O; int ldc;
    __device__ __forceinline__ void operator()(const f32x4 (&acc)[2][2][4][2], const Unit& u, int wr, int wc, int fr, int fq) const {
        const int row0 = u.pm * BM + wr * 64 + fr, col0 = u.pn * BM + wc * 32 + 8 * fq;
#pragma unroll
        for (int ai = 0; ai < 2; ++ai)
#pragma unroll
            for (int m = 0; m < 4; ++m) { bf16_t* rowp = O + (size_t)(row0 + ai * HALF + m * 16) * ldc + col0;
#pragma unroll
                for (int bj = 0; bj < 2; ++bj) { const f32x4 v0 = acc[ai][bj][m][0], v1 = acc[ai][bj][m][1];
                    u32x4 w; w.x = cvt_pk_bf16(fast_sigmoid(v0[0]), fast_sigmoid(v0[1])); w.y = cvt_pk_bf16(fast_sigmoid(v0[2]), fast_sigmoid(v0[3]));
                    w.z = cvt_pk_bf16(fast_sigmoid(v1[0]), fast_sigmoid(v1[1])); w.w = cvt_pk_bf16(fast_sigmoid(v1[2]), fast_sigmoid(v1[3]));
                    *(u32x4*)(rowp + bj * HALF) = w; } }
    }
};
template <int ACT> struct EpiMulBf16 {
    static constexpr bool PERM = true, AFTER_DRAIN = false;
    const bf16_t* F; int ldf; bf16_t* O; int ldc;
    __device__ __forceinline__ void operator()(const f32x4 (&acc)[2][2][4][2], const Unit& u, int wr, int wc, int fr, int fq) const {
        const int row0 = u.pm * BM + wr * 64 + fr, col0 = u.pn * BM + wc * 32 + 8 * fq;
#pragma unroll
        for (int ai = 0; ai < 2; ++ai)
#pragma unroll
            for (int m = 0; m < 4; ++m) { const size_t r = (size_t)(row0 + ai * HALF + m * 16);
#pragma unroll
                for (int bj = 0; bj < 2; ++bj) { const f32x4 v0 = acc[ai][bj][m][0], v1 = acc[ai][bj][m][1];
                    const u32x4 f = *(const u32x4*)(F + r * ldf + col0 + bj * HALF);
                    float a[8] = {v0[0], v0[1], v0[2], v0[3], v1[0], v1[1], v1[2], v1[3]};
                    if (ACT == 1) {
#pragma unroll
                        for (int j = 0; j < 8; ++j) a[j] = fast_silu(a[j]);
                    }
                    u32x4 w; w.x = cvt_pk_bf16(bflo(f.x) * a[0], bfhi(f.x) * a[1]); w.y = cvt_pk_bf16(bflo(f.y) * a[2], bfhi(f.y) * a[3]);
                    w.z = cvt_pk_bf16(bflo(f.z) * a[4], bfhi(f.z) * a[5]); w.w = cvt_pk_bf16(bflo(f.w) * a[6], bfhi(f.w) * a[7]);
                    *(u32x4*)(O + r * ldc + col0 + bj * HALF) = w; } }
    }
};
}

struct Frame {
    LAS unsigned char* lds;
    volatile LAS unsigned* MISC; gu32* ctl;
    int tid, lane, wave, G, vcu;
    const float* in[20]; float* out; unsigned char* ws;
};

__device__ __forceinline__ void tr_item(const float* W, int ld_src, int k0, int c0, bf16* WT, int ld_dst, int r0, int dk0, LAS float* scr, int lane) {
#pragma unroll 8
    for (int i = 0; i < 32; ++i) { const int kk = 2 * i + (lane >> 5); scr[kk * 33 + (lane & 31)] = W[(size_t)(k0 + kk) * ld_src + c0 + (lane & 31)]; }
    LDS_WAIT(); asm volatile("" ::: "memory");
    const int c = lane & 7;
#pragma unroll
    for (int j = 0; j < 4; ++j) { const int n = (lane >> 3) + 8 * j; const LAS float* s = scr + (8 * c) * 33 + n;
        v4u o; o.x = pk2(s[0 * 33], s[1 * 33]); o.y = pk2(s[2 * 33], s[3 * 33]); o.z = pk2(s[4 * 33], s[5 * 33]); o.w = pk2(s[6 * 33], s[7 * 33]);
        *(GAS v4u*)(WT + (size_t)(r0 + n) * ld_dst + dk0 + k0 + 8 * c) = o; }
    LDS_WAIT(); asm volatile("" ::: "memory");
}

__device__ __forceinline__ void p0_prologue(Frame& F) {
    LAS float* scr = (LAS float*)(F.lds + RING_OFF + F.wave * 16384);
    const int gw = F.vcu * NWAVES + F.wave, NGW = F.G * NWAVES;
    unsigned char* ws = F.ws;
    constexpr int I_FIN = (D / 64) * (NFF_IN / 32);
    constexpr int I_FOUT = (FF / 64) * (D / 32);
    constexpr int I_QKV = (D / 64) * (3072 / 32);
    constexpr int I_XP = (D / 64) * (512 / 32);
    constexpr int I_Z = (D / 64) * (1024 / 32);
    constexpr int I_G = (D / 64) * (2048 / 32);
    constexpr int I_SQ = (D / 64) * (D / 32);
    constexpr int NITEMS = 2 * I_FIN + 2 * I_FOUT + I_QKV + I_XP + I_Z + I_G + 3 * I_SQ;
    for (int it = gw; it < NITEMS; it += NGW) {
        int r = it;
        if (r < 2 * I_FIN) { const int which = r / I_FIN; r -= which * I_FIN; const int kb = r / 176, cb = r % 176;
            const int half = cb / 88, c2 = cb % 88, p = c2 / 4, w = c2 % 4;
            tr_item((which ? F.in[7] : F.in[5]), NFF_IN, 64 * kb, 32 * cb, (bf16*)(ws + (which ? WS_W2IN : WS_W1IN)), D, 256 * p + 128 * half + 32 * w, 0, scr, F.lane); continue; }
        r -= 2 * I_FIN;
        if (r < 2 * I_FOUT) { const int which = r / I_FOUT; r -= which * I_FOUT; const int kb = r / 32, cb = r % 32;
            tr_item((which ? F.in[8] : F.in[6]), D, 64 * kb, 32 * cb, (bf16*)(ws + (which ? WS_W2OUT : WS_W1OUT)), FF, 32 * cb, 0, scr, F.lane); continue; }
        r -= 2 * I_FOUT;
        if (r < I_QKV) { const int kb = r / 96, cb = r % 96; tr_item(F.in[9], MIXW, 64 * kb, 512 + 32 * cb, (bf16*)(ws + WS_WM1), D, 32 * cb, 0, scr, F.lane); continue; }
        r -= I_QKV;
        if (r < I_XP) { const int kb = r / 16, cb = r % 16; tr_item(F.in[9], MIXW, 64 * kb, 32 * cb, (bf16*)(ws + WS_WM1), D, 3072 + 32 * cb, 0, scr, F.lane); continue; }
        r -= I_XP;
        if (r < I_Z) { const int kb = r / 32, cb = r % 32; tr_item(F.in[9], MIXW, 64 * kb, 3584 + 32 * cb, (bf16*)(ws + WS_WZ), D, 32 * cb, 0, scr, F.lane); continue; }
        r -= I_Z;
        if (r < I_G) { const int kb = r / 64, cb = r % 64; tr_item(F.in[9], MIXW, 64 * kb, 4624 + 32 * cb, (bf16*)(ws + WS_WG), D, 32 * cb, 0, scr, F.lane); continue; }
        r -= I_G;
        { const int which = r / I_SQ; r -= which * I_SQ; const int kb = r / 32, cb = r % 32;
          if (which == 0) tr_item(F.in[17], D, 64 * kb, 32 * cb, (bf16*)(ws + WS_WDN), D, 32 * cb, 0, scr, F.lane);
          else tr_item(F.in[18], D, 64 * kb, 32 * cb, (bf16*)(ws + WS_WMO2), 2 * D, 32 * cb, (which - 1) * D, scr, F.lane); }
    }
    {
        bf16* wm1 = (bf16*)(ws + WS_WM1);
        for (int it = gw; it < 16 * 16; it += NGW) { const int n = it & 15, k = (it >> 4) * 64 + F.lane; wm1[(size_t)(3584 + n) * D + k] = (bf16)f2bf(F.in[9][(size_t)k * MIXW + 4608 + n]); }
        for (int it = gw; it < 240 * D / 8 / 64; it += NGW) *(GAS v4u*)(wm1 + (size_t)3600 * D + ((size_t)it * 64 + F.lane) * 8) = (v4u){0u, 0u, 0u, 0u};
    }
    {
        const float* pw = F.in[14]; const float* ps = F.in[15]; const float* pp = F.in[16];
        float* wpp32 = (float*)(ws + WS_WPP32);
        for (int it = gw; it < 512 * 16; it += NGW) {
            const int k = it >> 4, g = k >> 7, n = (it & 15) * 64 + F.lane;
            float a = 0.f;
#pragma unroll 8
            for (int d = 0; d < 128; ++d) a += (pw[(size_t)k * 128 + d] * ps[g * 128 + d]) * pp[(size_t)(g * 128 + d) * D + n];
            wpp32[(size_t)k * D + n] = a;
        }
    }
    {
        __syncthreads();
        LAS float* sc = (LAS float*)(F.lds + 65536);
        LAS float* red = (LAS float*)(F.lds);
        for (int e = F.tid; e < 4 * D; e += NWAVES * 64) { const float cv = F.in[1][e]; sc[e] = cv / (1.0f + expf(-cv)); }
        __syncthreads();
        const float* aw = F.in[2]; const float* ab = F.in[3]; float* mod = (float*)(ws + WS_MOD);
        for (int it = F.vcu; it < NMOD / 64; it += F.G) {
            const int n = it * 64 + F.lane; float a0 = 0.f, a1 = 0.f, a2 = 0.f, a3 = 0.f;
#pragma unroll 16
            for (int kk = 0; kk < 128; ++kk) { const int k = F.wave * 128 + kk; const float w = aw[(size_t)k * NMOD + n];
                a0 += sc[k] * w; a1 += sc[D + k] * w; a2 += sc[2 * D + k] * w; a3 += sc[3 * D + k] * w; }
            red[(F.wave * 4 + 0) * 64 + F.lane] = a0; red[(F.wave * 4 + 1) * 64 + F.lane] = a1; red[(F.wave * 4 + 2) * 64 + F.lane] = a2; red[(F.wave * 4 + 3) * 64 + F.lane] = a3;
            __syncthreads();
            if (F.tid < 256) { const int b = F.tid >> 6, l = F.tid & 63; float s = ab[it * 64 + l];
#pragma unroll
                for (int w = 0; w < 8; ++w) s += red[(w * 4 + b) * 64 + l];
                mod[(size_t)b * NMOD + it * 64 + l] = s; }
            __syncthreads();
        }
    }
}

__device__ __forceinline__ void normmod_rows(Frame& F, const float* X, bf16* H, const float* g, int sub) {
    const int gw = F.vcu * NWAVES + F.wave, NGW = F.G * NWAVES;
    const float* mod = (const float*)(F.ws + WS_MOD);
    for (int m = gw; m < M; m += NGW) {
        const GAS f32x4* xr = (const GAS f32x4*)(X + (size_t)m * D) + F.lane;
        f32x4 v[4]; float s = 0.f;
#pragma unroll
        for (int j = 0; j < 4; ++j) { v[j] = xr[64 * j]; s += (v[j].x * v[j].x + v[j].y * v[j].y) + (v[j].z * v[j].z + v[j].w * v[j].w); }
        const float rs = 1.0f / sqrtf(wave_sum(s) * (1.f / D) + RMS_EPS);
        const float* mb = mod + (size_t)(m / T) * NMOD + sub * 3 * D;
        GAS v2u* o8 = (GAS v2u*)(H + (size_t)m * D) + F.lane;
#pragma unroll
        for (int j = 0; j < 4; ++j) { const int col = 4 * (64 * j + F.lane);
            const f32x4 gg = *(const f32x4*)(g + col), sh = *(const f32x4*)(mb + col), sc = *(const f32x4*)(mb + D + col);
            const f32x4 o = (v[j] * rs * gg) * (sc + 1.0f) + sh;
            v2u w; w.x = pk2(o.x, o.y); w.y = pk2(o.z, o.w); o8[64 * j] = w; }
    }
}
__device__ __forceinline__ void final_norm_rows(Frame& F, const float* X, float* O, const float* g) {
    const int gw = F.vcu * NWAVES + F.wave, NGW = F.G * NWAVES;
    for (int m = gw; m < M; m += NGW) {
        const GAS f32x4* xr = (const GAS f32x4*)(X + (size_t)m * D) + F.lane;
        f32x4 v[4]; float s = 0.f;
#pragma unroll
        for (int j = 0; j < 4; ++j) { v[j] = xr[64 * j]; s += (v[j].x * v[j].x + v[j].y * v[j].y) + (v[j].z * v[j].z + v[j].w * v[j].w); }
        const float rs = 1.0f / sqrtf(wave_sum(s) * (1.f / D) + RMS_EPS);
        GAS f32x4* orow = (GAS f32x4*)(O + (size_t)m * D) + F.lane;
#pragma unroll
        for (int j = 0; j < 4; ++j) { const f32x4 gg = *(const f32x4*)(g + 4 * (64 * j + F.lane)); orow[64 * j] = v[j] * rs * gg; }
    }
}
__device__ __forceinline__ void pool_phase(Frame& F) {
    const bf16* xp = (const bf16*)(F.ws + WS_XP); bf16* pooled = (bf16*)(F.ws + WS_POOLED);
    const int gw = F.vcu * NWAVES + F.wave, NGW = F.G * NWAVES;
    const int c0 = F.lane * 8, w = 2 << (F.lane >> 4);
    for (int row = gw; row < M; row += NGW) {
        const int t = row % T, cnt = (t + 1) < w ? (t + 1) : w;
        float sum[8] = {0.f, 0.f, 0.f, 0.f, 0.f, 0.f, 0.f, 0.f}, xv[8] = {0.f, 0.f, 0.f, 0.f, 0.f, 0.f, 0.f, 0.f};
#pragma unroll
        for (int s = 0; s < 16; ++s) {
            if (s < cnt) { const v4u x = *(const GAS v4u*)(xp + (size_t)(row - s) * POOLW + c0);
                const float f[8] = {bflo(x.x), bfhi(x.x), bflo(x.y), bfhi(x.y), bflo(x.z), bfhi(x.z), bflo(x.w), bfhi(x.w)};
#pragma unroll
                for (int j = 0; j < 8; ++j) { sum[j] += f[j]; if (s == 0) xv[j] = f[j]; } }
        }
        const float inv = 1.0f / (float)cnt;
        v4u ov; ov.x = pk2(sum[0] * inv - xv[0], sum[1] * inv - xv[1]); ov.y = pk2(sum[2] * inv - xv[2], sum[3] * inv - xv[3]);
        ov.z = pk2(sum[4] * inv - xv[4], sum[5] * inv - xv[5]); ov.w = pk2(sum[6] * inv - xv[6], sum[7] * inv - xv[7]);
        *(GAS v4u*)(pooled + (size_t)row * POOLW + c0) = ov;
    }
}

constexpr int DN_EX_UNIT = 24576;
typedef short bf16x8v __attribute__((ext_vector_type(8)));
typedef float f32x4v __attribute__((ext_vector_type(4)));
__device__ __forceinline__ unsigned char* sub_ptr(unsigned char* base, int off) { return base + (size_t)(off >> 8) * 6144 + (off & 255); }
__device__ __forceinline__ bf16x8v pack8(float a0, float a1, float a2, float a3, float a4, float a5, float a6, float a7) {
    v4u w; w.x = pg8::cvt_pk_bf16(a0, a1); w.y = pg8::cvt_pk_bf16(a2, a3); w.z = pg8::cvt_pk_bf16(a4, a5); w.w = pg8::cvt_pk_bf16(a6, a7); return __builtin_bit_cast(bf16x8v, w); }
#define MFMA_BF16(a, b, c) __builtin_amdgcn_mfma_f32_16x16x32_bf16((a), (b), (c), 0, 0, 0)
#define MFMA_F32(a, b, c) __builtin_amdgcn_mfma_f32_16x16x4f32((a), (b), (c), 0, 0, 0)

constexpr int DA_QH = 0, DA_KH = 17408, DA_KT = 34816, DA_VT = 53248, DA_AM = 71680, DA_TM = 89088, DA_TF = 106496, DA_VEC = 122880, PT = 68;

__device__ __forceinline__ void dn_pre_phase(Frame& F) {
    LAS unsigned char* L = F.lds;
    LAS float* AM = (LAS float*)(L + DA_AM); LAS float* TM = (LAS float*)(L + DA_TM);
    LAS float* v_gc = (LAS float*)(L + DA_VEC); LAS float* v_bet = v_gc + 64; LAS float* v_bg = v_gc + 128; LAS float* v_kds = v_gc + 192; LAS float* v_qs = v_gc + 256;
    const int wave = F.wave;
    unsigned char* ws = F.ws;
#define DN_LBAR() do { asm volatile("s_waitcnt lgkmcnt(0)" ::: "memory"); __builtin_amdgcn_s_barrier(); asm volatile("" ::: "memory"); } while (0)
    const float* conv_w = F.in[10];
#define DN_OPAQUE_LANE() int tid = F.tid; asm volatile("" : "+v"(tid)); const int lane = tid & 63, q = lane >> 4, l15 = lane & 15; (void)q; (void)l15
#define DN_LOAD_RAW(UNIT) do { if (F.tid < 384 && (UNIT) < 32 * 64) { const int u_ = (UNIT), bh_ = u_ >> 6, n_ = u_ & 63, b_ = bh_ >> 3, h_ = bh_ & 7; \
        const int grp_ = F.tid >> 4, cg_ = F.tid & 15, rb_ = grp_ / 3, tensor_ = grp_ - 3 * rb_; \
        const bf16* src_ = (const bf16*)(ws + WS_QKV + (((size_t)b_ * T + 64 * n_) * 3072 + h_ * 128) * 2 + tensor_ * 2048) + 8 * cg_; \
        const bf16* hal_ = (const bf16*)(ws + WS_HALO) + ((size_t)(b_ * 64 + n_ - 1) * 3) * 3072 + tensor_ * 1024 + h_ * 128 + 8 * cg_; \
        _Pragma("unroll") for (int k = 0; k < 11; ++k) { const int rr = 8 * rb_ - 3 + k; \
            if (rr >= 0) xr[k] = *(const GAS v4u*)(src_ + (size_t)rr * 3072); \
            else if (n_ > 0) xr[k] = *(const GAS v4u*)(hal_ + (size_t)(rr + 3) * 3072); \
            else xr[k] = (v4u){0u, 0u, 0u, 0u}; } \
        _Pragma("unroll") for (int j = 0; j < 4; ++j) { cwv[2 * j] = *(const f32x4*)(conv_w + j * 3072 + tensor_ * 1024 + h_ * 128 + 8 * cg_); cwv[2 * j + 1] = *(const f32x4*)(conv_w + j * 3072 + tensor_ * 1024 + h_ * 128 + 8 * cg_ + 4); } } } while (0)
    v4u xr[11]; f32x4 cwv[8];
    DN_LOAD_RAW(F.vcu);
    for (int unit = F.vcu; unit < 32 * 64; unit += F.G) {
        const int bh = unit >> 6, n = unit & 63, b = bh >> 3, h = bh & 7;
        const size_t row_base = (size_t)b * T + 64 * n;
        unsigned char* qbase = ws + WS_QKV + (row_base * 3072 + h * 128) * 2;
        unsigned char* exu = ws + WS_EX + (size_t)unit * DN_EX_UNIT;
#ifndef REP_S0
#define REP_S0 1
#define REP_S1 1
#define REP_S2 1
#define REP_S3 1
#endif
        _Pragma("unroll 1") for (int rep0 = 0; rep0 < REP_S0; ++rep0) {
        { DN_OPAQUE_LANE();
        if (tid < 384) {
#ifndef REP_A
#define REP_A 1
#define REP_B 1
#endif
          _Pragma("unroll 1") for (int repa = 0; repa < REP_A; ++repa) {
            asm volatile("" : "+v"(tid));
            const int grp = tid >> 4, cg = tid & 15, rb = grp / 3, tensor = grp - 3 * rb;
            float cw[4][8];
#pragma unroll
            for (int j = 0; j < 4; ++j) { const f32x4 c0 = cwv[2 * j], c1 = cwv[2 * j + 1];
                cw[j][0] = c0.x; cw[j][1] = c0.y; cw[j][2] = c0.z; cw[j][3] = c0.w; cw[j][4] = c1.x; cw[j][5] = c1.y; cw[j][6] = c1.z; cw[j][7] = c1.w; }
            float y[8][8], ss[8];
#pragma unroll
            for (int r = 0; r < 8; ++r) {
                ss[r] = 0.f;
#pragma unroll
                for (int c = 0; c < 8; ++c) {
                    float a = 0.f;
#pragma unroll
                    for (int j = 0; j < 4; ++j) { const unsigned wv = (c >> 1) == 0 ? xr[r + j].x : (c >> 1) == 1 ? xr[r + j].y : (c >> 1) == 2 ? xr[r + j].z : xr[r + j].w;
                        a += cw[j][c] * ((c & 1) ? bfhi(wv) : bflo(wv)); }
                    a = a * __builtin_amdgcn_rcpf(1.0f + __builtin_amdgcn_exp2f(-1.4426950408889634f * a));
                    y[r][c] = a; ss[r] += a * a;
                }
            }
#define DN_DPP_ADD(x, ctrl) x += __builtin_bit_cast(float, __builtin_amdgcn_update_dpp(0, __builtin_bit_cast(int, x), ctrl, 0xf, 0xf, false))
#pragma unroll
            for (int r = 0; r < 8; ++r) DN_DPP_ADD(ss[r], 0xB1);
#pragma unroll
            for (int r = 0; r < 8; ++r) DN_DPP_ADD(ss[r], 0x4E);
#pragma unroll
            for (int r = 0; r < 8; ++r) DN_DPP_ADD(ss[r], 0x141);
#pragma unroll
            for (int r = 0; r < 8; ++r) DN_DPP_ADD(ss[r], 0x140);
#undef DN_DPP_ADD
            v4u yp[8];
#pragma unroll
            for (int r = 0; r < 8; ++r) {
                const float sc = tensor == 2 ? 1.0f : __builtin_amdgcn_rsqf(ss[r] + L2_EPS) * (tensor == 0 ? 0.08838834764831845f : 1.0f);
                v4u w; w.x = pg8::cvt_pk_bf16(y[r][0] * sc, y[r][1] * sc); w.y = pg8::cvt_pk_bf16(y[r][2] * sc, y[r][3] * sc); w.z = pg8::cvt_pk_bf16(y[r][4] * sc, y[r][5] * sc); w.w = pg8::cvt_pk_bf16(y[r][6] * sc, y[r][7] * sc);
                yp[r] = w;
                if (tensor < 2) *(LAS v4u*)(L + (tensor == 0 ? DA_QH : DA_KH) + (8 * rb + r) * 272 + 16 * cg) = w;
            }
            if (tensor >= 1) {
                LAS unsigned char* TT = L + (tensor == 1 ? DA_KT : DA_VT);
#pragma unroll
                for (int c = 0; c < 8; ++c) {
                    unsigned hw[8];
#pragma unroll
                    for (int r = 0; r < 8; ++r) { const unsigned wv = (c >> 1) == 0 ? yp[r].x : (c >> 1) == 1 ? yp[r].y : (c >> 1) == 2 ? yp[r].z : yp[r].w; hw[r] = (c & 1) ? (wv >> 16) : (wv & 0xffffu); }
                    v4u o; o.x = hw[0] | (hw[1] << 16); o.y = hw[2] | (hw[3] << 16); o.z = hw[4] | (hw[5] << 16); o.w = hw[6] | (hw[7] << 16);
                    *(LAS v4u*)(TT + (8 * cg + c) * 144 + 16 * (rb ^ (cg & 7))) = o;
                }
            }
          }
        } else if (wave == 6) {
          _Pragma("unroll 1") for (int repb = 0; repb < REP_B; ++repb) {
            asm volatile("" : "+v"(tid));
            const size_t rr = (row_base + lane) * 8 + h;
            float gv = ((const float*)(ws + WS_GL))[rr]; const float bt = ((const float*)(ws + WS_BETA))[rr];
#pragma unroll
            for (int o = 1; o < 64; o <<= 1) { const float t = __shfl_up(gv, o); if (lane >= o) gv += t; }
            const float g63 = __shfl(gv, 63);
            v_gc[lane] = gv; v_bet[lane] = bt; v_bg[lane] = bt * __expf(gv); v_kds[lane] = __expf(g63 - gv); v_qs[lane] = __expf(gv);
            if (lane == 0) ((float*)(ws + WS_EGB))[unit] = __expf(g63);
          }
        } else {
            for (int e = lane; e < 64 * PT; e += 64) TM[e] = 0.f;
        } }
        DN_LBAR();
        }
        DN_LOAD_RAW(unit + F.G);
#define DN_SB() __builtin_amdgcn_sched_barrier(0)
        _Pragma("unroll 1") for (int rep1 = 0; rep1 < REP_S1; ++rep1) {
        { DN_OPAQUE_LANE();
        if (wave < 5) {
            const int ti0 = 2 * wave, it0 = ti0 >= 6 ? 3 : ti0 >= 3 ? 2 : ti0 >= 1 ? 1 : 0, jt0 = ti0 - (it0 * (it0 + 1)) / 2;
            const int ti1 = ti0 + 1, it1 = ti1 >= 6 ? 3 : ti1 >= 3 ? 2 : ti1 >= 1 ? 1 : 0, jt1 = ti1 - (it1 * (it1 + 1)) / 2;
            bf16x8v a0[4], b0[4], a1[4], b1[4];
#pragma unroll
            for (int ks = 0; ks < 4; ++ks) {
                a0[ks] = *(const LAS bf16x8v*)(L + DA_KH + (16 * it0 + l15) * 272 + (32 * ks + 8 * q) * 2); b0[ks] = *(const LAS bf16x8v*)(L + DA_KH + (16 * jt0 + l15) * 272 + (32 * ks + 8 * q) * 2);
                a1[ks] = *(const LAS bf16x8v*)(L + DA_KH + (16 * it1 + l15) * 272 + (32 * ks + 8 * q) * 2); b1[ks] = *(const LAS bf16x8v*)(L + DA_KH + (16 * jt1 + l15) * 272 + (32 * ks + 8 * q) * 2); }
            const float gj0 = v_gc[16 * jt0 + l15], gj1 = v_gc[16 * jt1 + l15];
            const f32x4v gi0 = *(const LAS f32x4v*)(v_gc + 16 * it0 + 4 * q), gi1 = *(const LAS f32x4v*)(v_gc + 16 * it1 + 4 * q), bi0 = *(const LAS f32x4v*)(v_bet + 16 * it0 + 4 * q), bi1 = *(const LAS f32x4v*)(v_bet + 16 * it1 + 4 * q);
            DN_SB();
            f32x4v c0 = {0.f, 0.f, 0.f, 0.f}, c1 = {0.f, 0.f, 0.f, 0.f};
#pragma unroll
            for (int ks = 0; ks < 4; ++ks) { c0 = MFMA_BF16(a0[ks], b0[ks], c0); c1 = MFMA_BF16(a1[ks], b1[ks], c1); }
            DN_SB();
#pragma unroll
            for (int r = 0; r < 4; ++r) {
                { const int i = 16 * it0 + 4 * q + r, j = 16 * jt0 + l15; AM[i * PT + j] = (i > j) ? bi0[r] * c0[r] * __builtin_amdgcn_exp2f(1.4426950408889634f * (gi0[r] - gj0)) : 0.f; }
                { const int i = 16 * it1 + 4 * q + r, j = 16 * jt1 + l15; AM[i * PT + j] = (i > j) ? bi1[r] * c1[r] * __builtin_amdgcn_exp2f(1.4426950408889634f * (gi1[r] - gj1)) : 0.f; }
            }
        } else {
#pragma unroll
            for (int jb = 0; jb < 2; ++jb) {
                const int it = (wave == 5) ? (jb ? 3 : 0) : (wave == 6) ? (jb ? 3 : 1) : 2, ksp = (wave == 5) ? jb : (wave == 6) ? 0 : jb;
                const int jtA = 2 * ksp, jtB = 2 * ksp + 1; const bool hasB = jtB <= it;
                bf16x8v ka[4], kb[4], qb[4];
#pragma unroll
                for (int ks = 0; ks < 4; ++ks) {
                    ka[ks] = *(const LAS bf16x8v*)(L + DA_KH + (16 * jtA + l15) * 272 + (32 * ks + 8 * q) * 2);
                    kb[ks] = *(const LAS bf16x8v*)(L + DA_KH + (16 * (hasB ? jtB : jtA) + l15) * 272 + (32 * ks + 8 * q) * 2);
                    qb[ks] = *(const LAS bf16x8v*)(L + DA_QH + (16 * it + l15) * 272 + (32 * ks + 8 * q) * 2); }
                const float gi = v_gc[16 * it + l15];
                const f32x4v gjA = *(const LAS f32x4v*)(v_gc + 16 * jtA + 4 * q), gjB = *(const LAS f32x4v*)(v_gc + 16 * (hasB ? jtB : jtA) + 4 * q);
                DN_SB();
                f32x4v cA = {0.f, 0.f, 0.f, 0.f}, cB = {0.f, 0.f, 0.f, 0.f};
#pragma unroll
                for (int ks = 0; ks < 4; ++ks) { cA = MFMA_BF16(ka[ks], qb[ks], cA); cB = MFMA_BF16(kb[ks], qb[ks], cB); }
                DN_SB();
                float o8[8]; const int i = 16 * it + l15;
#pragma unroll
                for (int r = 0; r < 4; ++r) {
                    o8[r] = (i >= 16 * jtA + 4 * q + r) ? cA[r] * __builtin_amdgcn_exp2f(1.4426950408889634f * (gi - gjA[r])) : 0.f;
                    o8[4 + r] = (hasB && i >= 16 * jtB + 4 * q + r) ? cB[r] * __builtin_amdgcn_exp2f(1.4426950408889634f * (gi - gjB[r])) : 0.f; }
                *(GAS bf16x8v*)(exu + 16384 + (it * 2 + ksp) * 1024 + lane * 16) = pack8(o8[0], o8[1], o8[2], o8[3], o8[4], o8[5], o8[6], o8[7]);
            }
        } }
        DN_LBAR();
        }
        DN_LOAD_RAW(unit + F.G);
        _Pragma("unroll 1") for (int rep2 = 0; rep2 < REP_S2; ++rep2) {
        if (wave == 0) {
            DN_OPAQUE_LANE(); const int bb = q, c = l15; float tc[16];
            f32x4v ar[16][4];
#pragma unroll
            for (int r = 1; r < 16; ++r)
#pragma unroll
                for (int v = 0; v < (r + 3) / 4; ++v) ar[r][v] = *(const LAS f32x4v*)(AM + (16 * bb + r) * PT + 16 * bb + 4 * v);
            DN_SB();
#pragma unroll
            for (int r = 0; r < 16; ++r) { float a = (r == c) ? 1.f : 0.f;
#pragma unroll
                for (int s = 0; s < r; ++s) a -= ar[r][s >> 2][s & 3] * tc[s];
                tc[r] = a; }
#pragma unroll
            for (int r = 0; r < 16; ++r) TM[(16 * bb + r) * PT + 16 * bb + c] = tc[r];
        }
        DN_LBAR();
#pragma unroll
        for (int lev = 1; lev <= 3; ++lev) {
            if (wave < 4 - lev) {
                DN_OPAQUE_LANE(); const int bc = wave, br = wave + lev;
                float xa[3][4], xb[3][4], ta[4];
#pragma unroll
                for (int mm = 0; mm < lev; ++mm)
#pragma unroll
                    for (int s2 = 0; s2 < 4; ++s2) { xa[mm][s2] = AM[(16 * br + l15) * PT + 16 * (bc + mm) + 4 * s2 + q]; xb[mm][s2] = TM[(16 * (bc + mm) + 4 * s2 + q) * PT + 16 * bc + l15]; }
#pragma unroll
                for (int s2 = 0; s2 < 4; ++s2) ta[s2] = TM[(16 * br + l15) * PT + 16 * br + 4 * q + s2];
                DN_SB();
                f32x4v Pm[3];
#pragma unroll
                for (int mm = 0; mm < lev; ++mm) Pm[mm] = (f32x4v){0.f, 0.f, 0.f, 0.f};
#pragma unroll
                for (int s2 = 0; s2 < 4; ++s2)
#pragma unroll
                    for (int mm = 0; mm < lev; ++mm) Pm[mm] = MFMA_F32(xa[mm][s2], xb[mm][s2], Pm[mm]);
                f32x4v P = Pm[0];
#pragma unroll
                for (int mm = 1; mm < lev; ++mm) P = P + Pm[mm];
                f32x4v R = {0.f, 0.f, 0.f, 0.f};
#pragma unroll
                for (int s2 = 0; s2 < 4; ++s2) R = MFMA_F32(ta[s2], P[s2], R);
#pragma unroll
                for (int r = 0; r < 4; ++r) TM[(16 * br + 4 * q + r) * PT + 16 * bc + l15] = -R[r];
            }
            DN_LBAR();
        }
        }
        {
            DN_OPAQUE_LANE(); const int f = tid >> 6, it = f >> 1, ksp = f & 1, i = 16 * it + l15;
            float a0[8], a1[8];
#pragma unroll
            for (int jj = 0; jj < 8; ++jj) { const int j = 32 * ksp + 8 * q + jj; const float t = TM[i * PT + j]; a0[jj] = t * v_bg[j]; a1[jj] = t * v_bet[j]; }
            *(LAS bf16x8v*)(L + DA_TF + f * 1024 + lane * 16) = pack8(a0[0], a0[1], a0[2], a0[3], a0[4], a0[5], a0[6], a0[7]);
            *(LAS bf16x8v*)(L + DA_TF + 8192 + f * 1024 + lane * 16) = pack8(a1[0], a1[1], a1[2], a1[3], a1[4], a1[5], a1[6], a1[7]);
        }
        DN_LBAR();
        _Pragma("unroll 1") for (int rep3 = 0; rep3 < REP_S3; ++rep3) {
            DN_OPAQUE_LANE(); const int it = wave & 3, kp = wave >> 2;
            f32x4v acc[4]; bf16x8v ka[4][2], tb[2];
#pragma unroll
            for (int ksp = 0; ksp < 2; ++ksp) { tb[ksp] = *(const LAS bf16x8v*)(L + DA_TF + (it * 2 + ksp) * 1024 + lane * 16);
#pragma unroll
                for (int dd = 0; dd < 4; ++dd) ka[dd][ksp] = *(const LAS bf16x8v*)(L + DA_KT + (16 * (4 * kp + dd) + l15) * 144 + (((4 * ksp + q) ^ (((16 * (4 * kp + dd) + l15) >> 3) & 7)) * 16)); }
            const int vt = wave; bf16x8v ta2[4][2], vb2[2];
#pragma unroll
            for (int ksp = 0; ksp < 2; ++ksp) { vb2[ksp] = *(const LAS bf16x8v*)(L + DA_VT + (16 * vt + l15) * 144 + (((4 * ksp + q) ^ (((16 * vt + l15) >> 3) & 7)) * 16));
#pragma unroll
                for (int i2 = 0; i2 < 4; ++i2) ta2[i2][ksp] = *(const LAS bf16x8v*)(L + DA_TF + 8192 + (i2 * 2 + ksp) * 1024 + lane * 16); }
            DN_SB();
#pragma unroll
            for (int dd = 0; dd < 4; ++dd) { acc[dd] = (f32x4v){0.f, 0.f, 0.f, 0.f};
#pragma unroll
                for (int ksp = 0; ksp < 2; ++ksp) { if (ksp == 1 && it < 2) continue; acc[dd] = MFMA_BF16(ka[dd][ksp], tb[ksp], acc[dd]); } }
            f32x4v au[4];
#pragma unroll
            for (int i2 = 0; i2 < 4; ++i2) { au[i2] = (f32x4v){0.f, 0.f, 0.f, 0.f};
#pragma unroll
                for (int ksp = 0; ksp < 2; ++ksp) { if (ksp == 1 && i2 < 2) continue; au[i2] = MFMA_BF16(ta2[i2][ksp], vb2[ksp], au[i2]); } }
            DN_SB();
#pragma unroll
            for (int e = 0; e < 2; ++e)
                *(GAS bf16x8v*)(exu + (it * 4 + 2 * kp + e) * 1024 + lane * 16) = pack8(-acc[2 * e][0], -acc[2 * e][1], -acc[2 * e][2], -acc[2 * e][3], -acc[2 * e + 1][0], -acc[2 * e + 1][1], -acc[2 * e + 1][2], -acc[2 * e + 1][3]);
            unsigned char* vb = qbase + 4096;
            *(GAS bf16x8v*)sub_ptr(vb, vt * 2048 + lane * 32) = pack8(au[0][0], au[0][1], au[0][2], au[0][3], au[1][0], au[1][1], au[1][2], au[1][3]);
            *(GAS bf16x8v*)sub_ptr(vb, vt * 2048 + lane * 32 + 16) = pack8(au[2][0], au[2][1], au[2][2], au[2][3], au[3][0], au[3][1], au[3][2], au[3][3]);
#pragma unroll
            for (int e = 0; e < 2; ++e) {
                const int f = 2 * wave + e;
                { const int it2 = f >> 2, ks = f & 3, i = 16 * it2 + l15; const float sc = v_qs[i];
                  const v2u p0 = *(const LAS v2u*)(L + DA_QH + i * 272 + (32 * ks + 4 * q) * 2), p1 = *(const LAS v2u*)(L + DA_QH + i * 272 + (32 * ks + 16 + 4 * q) * 2);
                  *(GAS bf16x8v*)sub_ptr(qbase, f * 1024 + lane * 16) = pack8(bflo(p0.x) * sc, bfhi(p0.x) * sc, bflo(p0.y) * sc, bfhi(p0.y) * sc, bflo(p1.x) * sc, bfhi(p1.x) * sc, bflo(p1.y) * sc, bfhi(p1.y) * sc); }
                { const int dt = f >> 1, ksp = f & 1, d = 16 * dt + l15, t0 = 32 * ksp + 4 * q, t1 = t0 + 16;
                  const int sw = (d >> 3) & 7;
                  const v2u p0 = *(const LAS v2u*)(L + DA_KT + d * 144 + (((t0 >> 3) ^ sw) * 16) + (t0 & 7) * 2), p1 = *(const LAS v2u*)(L + DA_KT + d * 144 + (((t1 >> 3) ^ sw) * 16) + (t1 & 7) * 2);
                  *(GAS bf16x8v*)sub_ptr(qbase + 2048, f * 1024 + lane * 16) = pack8(bflo(p0.x) * v_kds[t0], bfhi(p0.x) * v_kds[t0 + 1], bflo(p0.y) * v_kds[t0 + 2], bfhi(p0.y) * v_kds[t0 + 3],
                                                                                    bflo(p1.x) * v_kds[t1], bfhi(p1.x) * v_kds[t1 + 1], bflo(p1.y) * v_kds[t1 + 2], bfhi(p1.y) * v_kds[t1 + 3]); }
            }
        }
        DN_LBAR();
    }
#undef DN_OPAQUE_LANE
#undef DN_LOAD_RAW
#undef DN_LBAR
    __syncthreads();
}

constexpr int DB_WN = 0, DB_QP = 16384, DB_KD = 32768, DB_QK = 49152, DB_UP = 57344, DB_BUF = 65536, DB_OS = 126976, DB_PF = 129024;
__device__ __forceinline__ void dn_scan_phase(Frame& F) {
    LAS unsigned char* L = F.lds;
    const int lane = F.lane, wave = F.wave, q = lane >> 4, l15 = lane & 15;
    if (F.vcu >= 256) return;
    const int bh = F.vcu >> 3, vs = F.vcu & 7, b = bh >> 3, h = bh & 7;
    unsigned char* ws = F.ws;
    f32x4v S[8]; bf16x8v Sb[4];
#pragma unroll
    for (int i = 0; i < 8; ++i) S[i] = (f32x4v){0.f, 0.f, 0.f, 0.f};
#pragma unroll
    for (int i = 0; i < 4; ++i) Sb[i] = (bf16x8v){0, 0, 0, 0, 0, 0, 0, 0};
    const float eg_all = ((const float*)(ws + WS_EGB))[bh * 64 + lane];
#define DN_PIECE_SRC(c, pc, inner) ((pc) < 16 ? (const unsigned char*)(ws + WS_EX + (size_t)(bh * 64 + (c)) * DN_EX_UNIT + (pc) * 1024 + (inner)) : \
        (pc) < 48 ? (const unsigned char*)sub_ptr(ws + WS_QKV + (((size_t)b * T + 64 * (c)) * 3072 + h * 128) * 2 + ((pc) < 32 ? 0 : 2048), (((pc) - 16) & 15) * 1024 + (inner)) : \
        (pc) < 54 ? (const unsigned char*)(ws + WS_EX + (size_t)(bh * 64 + (c)) * DN_EX_UNIT + 16384 + (((pc) - 48) == 0 ? 0 : ((pc) - 48) == 1 ? 2 : ((pc) - 48) + 2) * 1024 + (inner)) : \
        (const unsigned char*)sub_ptr(ws + WS_QKV + (((size_t)b * T + 64 * (c)) * 3072 + h * 128) * 2 + 4096, (2 * vs + ((pc) - 54)) * 1024 + (inner)))
#define DN_PIECE_DST(pc) ((pc) < 16 ? DB_WN + (pc) * 1024 : (pc) < 32 ? DB_QP + ((pc) - 16) * 1024 : (pc) < 48 ? DB_KD + ((pc) - 32) * 1024 : \
        (pc) < 54 ? DB_QK + (((pc) - 48) == 0 ? 0 : ((pc) - 48) == 1 ? 2 : ((pc) - 48) + 2) * 1024 : DB_UP + ((pc) - 54) * 1024)
    constexpr int PFD = 3;
    for (int n = -1; n < 64; ++n) {
        if (wave == 7) {
            for (int c = (n < 0 ? 1 : n + 1 + PFD); c <= n + 1 + PFD && c < 64; ++c) {
#pragma unroll
                for (int e = 0; e < 7; ++e) { const int li = e * 64 + lane, pc = li >> 3, inner = (li & 7) * 128;
                    __builtin_amdgcn_global_load_lds((const unsigned*)DN_PIECE_SRC(c, pc, inner), (LAS unsigned*)(L + DB_PF), 4, 0, 0); }
            }
        } else if (wave != 0) {
            if (n + 1 < 64) {
                const int nn = n + 1;
                LAS unsigned char* buf = L + (nn & 1) * DB_BUF;
#pragma unroll
                for (int e = 0; e < 10; ++e) {
                    const int pc = (wave - 1) + 6 * e;
                    if (pc < 56) __builtin_amdgcn_global_load_lds((const unsigned*)DN_PIECE_SRC(nn, pc, lane * 16), (LAS unsigned*)(buf + DN_PIECE_DST(pc)), 16, 0, 0);
                }
            }
            asm volatile("s_waitcnt vmcnt(0)" ::: "memory");
        } else if (n >= 0) {
            const LAS unsigned char* buf = L + (n & 1) * DB_BUF;
#define DN_LD8(dst, off) do { _Pragma("unroll") for (int i_ = 0; i_ < 8; ++i_) dst[i_] = *(const LAS bf16x8v*)(buf + (off) + i_ * 1024 + lane * 16); } while (0)
#define DN_SB() __builtin_amdgcn_sched_barrier(0)
            bf16x8v f0[8], f1[8];
            const v4u u0 = *(const LAS v4u*)(buf + DB_UP + lane * 32), u1 = *(const LAS v4u*)(buf + DB_UP + lane * 32 + 16);
            DN_LD8(f0, DB_WN); DN_SB();
            DN_LD8(f1, DB_WN + 8192);
            f32x4v vn[4];
            vn[0] = (f32x4v){bflo(u0.x), bfhi(u0.x), bflo(u0.y), bfhi(u0.y)}; vn[1] = (f32x4v){bflo(u0.z), bfhi(u0.z), bflo(u0.w), bfhi(u0.w)};
            vn[2] = (f32x4v){bflo(u1.x), bfhi(u1.x), bflo(u1.y), bfhi(u1.y)}; vn[3] = (f32x4v){bflo(u1.z), bfhi(u1.z), bflo(u1.w), bfhi(u1.w)};
#pragma unroll
            for (int ks = 0; ks < 4; ++ks) { vn[0] = MFMA_BF16(f0[ks], Sb[ks], vn[0]); vn[1] = MFMA_BF16(f0[4 + ks], Sb[ks], vn[1]); }
            DN_SB();
            DN_LD8(f0, DB_KD);
#pragma unroll
            for (int ks = 0; ks < 4; ++ks) { vn[2] = MFMA_BF16(f1[ks], Sb[ks], vn[2]); vn[3] = MFMA_BF16(f1[4 + ks], Sb[ks], vn[3]); }
            DN_SB();
            bf16x8v vb[2];
            vb[0] = pack8(vn[0][0], vn[0][1], vn[0][2], vn[0][3], vn[1][0], vn[1][1], vn[1][2], vn[1][3]);
            vb[1] = pack8(vn[2][0], vn[2][1], vn[2][2], vn[2][3], vn[3][0], vn[3][1], vn[3][2], vn[3][3]);
            const float eg = __shfl(eg_all, n);
#pragma unroll
            for (int dt = 0; dt < 8; ++dt) S[dt] = S[dt] * eg;
            DN_LD8(f1, DB_KD + 8192);
#pragma unroll
            for (int dt = 0; dt < 4; ++dt) { S[dt] = MFMA_BF16(f0[2 * dt], vb[0], S[dt]); S[dt] = MFMA_BF16(f0[2 * dt + 1], vb[1], S[dt]); }
            DN_SB();
            DN_LD8(f0, DB_QP);
#pragma unroll
            for (int dt = 0; dt < 4; ++dt) { S[4 + dt] = MFMA_BF16(f1[2 * dt], vb[0], S[4 + dt]); S[4 + dt] = MFMA_BF16(f1[2 * dt + 1], vb[1], S[4 + dt]); }
            DN_SB();
            DN_LD8(f1, DB_QP + 8192);
            f32x4v oo[4];
#pragma unroll
            for (int it = 0; it < 4; ++it) oo[it] = (f32x4v){0.f, 0.f, 0.f, 0.f};
#pragma unroll
            for (int ks = 0; ks < 4; ++ks) { oo[0] = MFMA_BF16(f0[ks], Sb[ks], oo[0]); oo[1] = MFMA_BF16(f0[4 + ks], Sb[ks], oo[1]); }
            DN_SB();
            DN_LD8(f0, DB_QK);
#pragma unroll
            for (int ks = 0; ks < 4; ++ks) { oo[2] = MFMA_BF16(f1[ks], Sb[ks], oo[2]); oo[3] = MFMA_BF16(f1[4 + ks], Sb[ks], oo[3]); }
            DN_SB();
            oo[0] = MFMA_BF16(f0[0], vb[0], oo[0]); oo[1] = MFMA_BF16(f0[2], vb[0], oo[1]);
            oo[2] = MFMA_BF16(f0[4], vb[0], oo[2]); oo[2] = MFMA_BF16(f0[5], vb[1], oo[2]);
            oo[3] = MFMA_BF16(f0[6], vb[0], oo[3]); oo[3] = MFMA_BF16(f0[7], vb[1], oo[3]);
#pragma unroll
            for (int ks = 0; ks < 4; ++ks) Sb[ks] = pack8(S[2 * ks][0], S[2 * ks][1], S[2 * ks][2], S[2 * ks][3], S[2 * ks + 1][0], S[2 * ks + 1][1], S[2 * ks + 1][2], S[2 * ks + 1][3]);
            DN_SB();
#undef DN_LD8
            LAS unsigned short* OS = (LAS unsigned short*)(L + DB_OS);
#pragma unroll
            for (int it = 0; it < 4; ++it)
#pragma unroll
                for (int r = 0; r < 4; ++r) OS[(16 * it + 4 * q + r) * 16 + l15] = (unsigned short)f2bf(oo[it][r]);
            LDS_WAIT(); asm volatile("" ::: "memory");
            const v4u o0 = *(const LAS v4u*)(L + DB_OS + lane * 32), o1 = *(const LAS v4u*)(L + DB_OS + lane * 32 + 16);
            float ss = 0.f;
            { const unsigned ww[8] = {o0.x, o0.y, o0.z, o0.w, o1.x, o1.y, o1.z, o1.w};
#pragma unroll
              for (int k = 0; k < 8; ++k) { const float a = bflo(ww[k]), c = bfhi(ww[k]); ss += a * a + c * c; } }
            unsigned char* vbp = ws + WS_QKV + (((size_t)b * T + 64 * n) * 3072 + h * 128) * 2 + 4096;
            *(GAS v4u*)sub_ptr(vbp, vs * 2048 + lane * 32) = o0; *(GAS v4u*)sub_ptr(vbp, vs * 2048 + lane * 32 + 16) = o1;
            ((float*)(ws + WS_SSQ))[(size_t)(bh * 8 + vs) * T + 64 * n + lane] = ss;
            LDS_WAIT(); asm volatile("" ::: "memory");
        }
        asm volatile("" ::: "memory"); __builtin_amdgcn_s_barrier(); asm volatile("" ::: "memory");
    }
    asm volatile("s_waitcnt vmcnt(0)" ::: "memory");
    __syncthreads();
#undef DN_PIECE_SRC
#undef DN_PIECE_DST
}

__device__ __forceinline__ void onorm_phase(Frame& F) {
    unsigned char* ws = F.ws; const float* dn_g = F.in[13]; const float* ssq = (const float*)(ws + WS_SSQ); bf16* onorm = (bf16*)(ws + WS_ONORM);
    const int gt = (F.vcu * NWAVES + F.wave) * 64 + F.lane, NT = F.G * NWAVES * 64;
    for (int item = gt; item < M * 128; item += NT) {
        const int row = item >> 7, cgp = item & 127, h = cgp >> 4, c0 = (cgp & 15) * 8, b = row / T, t = row % T, n = t >> 6, tt = t & 63, vs = c0 >> 4, half = (c0 >> 3) & 1;
        unsigned char* vbp = ws + WS_QKV + (((size_t)b * T + 64 * n) * 3072 + h * 128) * 2 + 4096;
        const v4u o = *(const GAS v4u*)sub_ptr(vbp, vs * 2048 + tt * 32 + half * 16);
        float s = 0.f;
#pragma unroll
        for (int v2 = 0; v2 < 8; ++v2) s += ssq[(size_t)((b * 8 + h) * 8 + v2) * T + t];
        const float rs = 1.0f / sqrtf(s * (1.0f / 128.0f) + RMS_EPS);
        const f32x4 g0 = *(const f32x4*)(dn_g + c0), g1 = *(const f32x4*)(dn_g + c0 + 4);
        v4u w; w.x = pk2(bflo(o.x) * rs * g0.x, bfhi(o.x) * rs * g0.y); w.y = pk2(bflo(o.y) * rs * g0.z, bfhi(o.y) * rs * g0.w);
        w.z = pk2(bflo(o.z) * rs * g1.x, bfhi(o.z) * rs * g1.y); w.w = pk2(bflo(o.w) * rs * g1.z, bfhi(o.w) * rs * g1.w);
        *(GAS v4u*)(onorm + (size_t)row * 1024 + h * 128 + c0) = w;
    }
}

struct Args { const float* in[20]; float* out; unsigned char* ws; int ph_lo, ph_hi; };
constexpr int N_PHASES = 19;
__global__ void __launch_bounds__(NWAVES * 64, 2) mk_fwd(Args args) {
    extern __shared__ __attribute__((aligned(16))) unsigned char lds[];
    Frame F;
    F.lds = (LAS unsigned char*)lds;
    F.tid = threadIdx.x; F.lane = F.tid & 63; F.wave = __builtin_amdgcn_readfirstlane(F.tid >> 6);
    F.G = gridDim.x; { const int bx = blockIdx.x; F.vcu = (F.G % 8 == 0) ? (bx % 8) * (F.G / 8) + bx / 8 : bx; }
#pragma unroll
    for (int i = 0; i < 20; ++i) F.in[i] = args.in[i];
    F.out = args.out; F.ws = args.ws;
    unsigned char* ws = args.ws;
    F.MISC = (volatile LAS unsigned*)(F.lds + MISC_OFF); F.ctl = (gu32*)(ws + WS_CTL);
    for (int u = F.tid; u < (LDS_BYTES - LDSCTL_OFF) / 4; u += NWAVES * 64) ((LAS unsigned*)(F.lds + LDSCTL_OFF))[u] = 0u;
    __syncthreads();
    const bool one = (args.ph_hi - args.ph_lo) > 1;
    XcdBarrier bar; bar.bar = (unsigned*)(F.ctl + CW_BAR); bar.x = 0; bar.st = nullptr;
    if (one) bar = xcd_barrier_post((unsigned*)(F.ctl + CW_BAR), F.MISC + 8);
#define SEAM(k) do { if (IN(k) && IN((k) + 1)) xcd_barrier(bar); } while (0)
    const int lo = args.ph_lo, hi = args.ph_hi;
#define IN(k) (lo <= (k) && (k) < hi)
    bf16* Hb = (bf16*)(ws + WS_H);
    const float* mod = (const float*)(ws + WS_MOD);

    if (IN(0)) p0_prologue(F);
    SEAM(0);
    if (IN(1)) {
        LAS float* scr = (LAS float*)(F.lds + RING_OFF + F.wave * 16384);
        const int gw = F.vcu * NWAVES + F.wave, NGW = F.G * NWAVES;
        for (int it = gw; it < (512 / 64) * (D / 32); it += NGW) { const int kb = it / 32, cb = it % 32; tr_item((const float*)(ws + WS_WPP32), D, 64 * kb, 32 * cb, (bf16*)(ws + WS_WPP), 512, 32 * cb, 0, scr, F.lane); }
        normmod_rows(F, F.in[0], Hb, F.in[4] + 0 * D, 0);
    }
    SEAM(1);
    if (IN(2)) { pg8::Gemm g{Hb, (const bf16*)(ws + WS_W1IN), M, NFF_IN, D}; pg8::StaticOrder S; S.init(M, NFF_IN, F.G, (int)blockIdx.x);
        pg8::EpiSwiglu E{(bf16*)(ws + WS_HID), FF};
        pg8::gemm_phase<pg8::EpiSwiglu, pg8::StaticOrder, PG8_ALIGN, PG8_SP2>(F.lds + RING_OFF, g, S, E); }
    SEAM(2);
    if (IN(3)) { pg8::Gemm g{(const bf16*)(ws + WS_HID), (const bf16*)(ws + WS_W1OUT), M, D, FF}; pg8::StaticOrder S; S.init(M, D, F.G, (int)blockIdx.x);
        pg8::EpiResGate E{F.in[0], F.out, D, mod + 0 * 3 * D + 2 * D, NMOD, 0.5f};
        pg8::gemm_phase<pg8::EpiResGate, pg8::StaticOrder, PG8_ALIGN, PG8_SP2>(F.lds + RING_OFF, g, S, E); }
    SEAM(3);
    if (IN(4)) normmod_rows(F, F.out, Hb, F.in[4] + 1 * D, 1);
    SEAM(4);
    if (IN(5)) { pg8::Gemm g{Hb, (const bf16*)(ws + WS_WM1), M, NM1, D}; pg8::StaticOrder S; S.init(M, NM1, F.G, (int)blockIdx.x);
        pg8::EpiM1 E{(bf16*)(ws + WS_QKV), (bf16*)(ws + WS_XP), (float*)(ws + WS_BETA), (float*)(ws + WS_GL), F.in[11], F.in[12], (bf16*)(ws + WS_HALO)};
        pg8::gemm_phase<pg8::EpiM1, pg8::StaticOrder, PG8_ALIGN, PG8_SP2>(F.lds + RING_OFF, g, S, E); }
    SEAM(5);
    if (IN(6)) pool_phase(F);
    SEAM(6);
    if (IN(7)) dn_pre_phase(F);
    SEAM(7);
    if (IN(8)) dn_scan_phase(F);
    SEAM(8);
    if (IN(9)) onorm_phase(F);
    SEAM(9);
    if (IN(10)) { pg8::Gemm g{Hb, (const bf16*)(ws + WS_WG), M, 2048, D}; pg8::StaticOrder S; S.init(M, 2048, F.G, (int)blockIdx.x);
        pg8::EpiSigmoid E{(bf16*)(ws + WS_GATES), 2048};
        pg8::gemm_phase<pg8::EpiSigmoid, pg8::StaticOrder, PG8_ALIGN, PG8_SP2>(F.lds + RING_OFF, g, S, E); }
    SEAM(10);
    if (IN(11)) { pg8::Gemm g{Hb, (const bf16*)(ws + WS_WZ), M, D, D}; pg8::StaticOrder S; S.init(M, D, F.G, (int)blockIdx.x);
        pg8::EpiMulBf16<1> E{(const bf16*)(ws + WS_ONORM), D, (bf16*)(ws + WS_OG), D};
        pg8::gemm_phase<pg8::EpiMulBf16<1>, pg8::StaticOrder, PG8_ALIGN, PG8_SP2>(F.lds + RING_OFF, g, S, E); }
    SEAM(11);
    if (IN(12)) { pg8::Gemm g{(const bf16*)(ws + WS_POOLED), (const bf16*)(ws + WS_WPP), M, D, POOLW}; pg8::StaticOrder S; S.init(M, D, F.G, (int)blockIdx.x);
        pg8::EpiMulBf16<0> E{(const bf16*)(ws + WS_GATES), 2048, (bf16*)(ws + WS_TAB), 2048};
        pg8::gemm_phase<pg8::EpiMulBf16<0>, pg8::StaticOrder, PG8_ALIGN, PG8_SP2>(F.lds + RING_OFF, g, S, E); }
    SEAM(12);
    if (IN(13)) { pg8::Gemm g{(const bf16*)(ws + WS_OG), (const bf16*)(ws + WS_WDN), M, D, D}; pg8::StaticOrder S; S.init(M, D, F.G, (int)blockIdx.x);
        pg8::EpiMulBf16<0> E{(const bf16*)(ws + WS_GATES) + 1024, 2048, (bf16*)(ws + WS_TAB) + 1024, 2048};
        pg8::gemm_phase<pg8::EpiMulBf16<0>, pg8::StaticOrder, PG8_ALIGN, PG8_SP2>(F.lds + RING_OFF, g, S, E); }
    SEAM(13);
    if (IN(14)) { pg8::Gemm g{(const bf16*)(ws + WS_TAB), (const bf16*)(ws + WS_WMO2), M, D, 2 * D}; pg8::StaticOrder S; S.init(M, D, F.G, (int)blockIdx.x);
        pg8::EpiResGate E{F.out, F.out, D, mod + 1 * 3 * D + 2 * D, NMOD, 1.0f};
        pg8::gemm_phase<pg8::EpiResGate, pg8::StaticOrder, PG8_ALIGN, PG8_SP2>(F.lds + RING_OFF, g, S, E); }
    SEAM(14);
    if (IN(15)) normmod_rows(F, F.out, Hb, F.in[4] + 2 * D, 2);
    SEAM(15);
    if (IN(16)) { pg8::Gemm g{Hb, (const bf16*)(ws + WS_W2IN), M, NFF_IN, D}; pg8::StaticOrder S; S.init(M, NFF_IN, F.G, (int)blockIdx.x);
        pg8::EpiSwiglu E{(bf16*)(ws + WS_HID), FF};
        pg8::gemm_phase<pg8::EpiSwiglu, pg8::StaticOrder, PG8_ALIGN, PG8_SP2>(F.lds + RING_OFF, g, S, E); }
    SEAM(16);
    if (IN(17)) { pg8::Gemm g{(const bf16*)(ws + WS_HID), (const bf16*)(ws + WS_W2OUT), M, D, FF}; pg8::StaticOrder S; S.init(M, D, F.G, (int)blockIdx.x);
        pg8::EpiResGate E{F.out, F.out, D, mod + 2 * 3 * D + 2 * D, NMOD, 0.5f};
        pg8::gemm_phase<pg8::EpiResGate, pg8::StaticOrder, PG8_ALIGN, PG8_SP2>(F.lds + RING_OFF, g, S, E); }
    SEAM(17);
    if (IN(18)) final_norm_rows(F, F.out, F.out, F.in[19]);
#undef IN
#undef SEAM
}

extern "C" void kernel_launch(void* const* d_in, const int* in_sizes, int n_in, void* d_out, int out_size, void* d_ws, size_t ws_size, hipStream_t stream) {
    static int grid = 0;
    if (grid == 0) {
        if (n_in != 20 || in_sizes[0] != M * D || out_size != M * D || ws_size < WS_END) { fprintf(stderr, "kernel_launch: unexpected shapes (n_in %d, in0 %d, out %d, ws %zu)\n", n_in, n_in > 0 ? in_sizes[0] : -1, out_size, ws_size); grid = -1; return; }
        int dev = 0, cus = 0;
        if (hipGetDevice(&dev) != hipSuccess || hipDeviceGetAttribute(&cus, hipDeviceAttributeMultiprocessorCount, dev) != hipSuccess) { grid = -1; return; }
        if (hipFuncSetAttribute((const void*)mk_fwd, hipFuncAttributeMaxDynamicSharedMemorySize, LDS_BYTES) != hipSuccess) { fprintf(stderr, "kernel_launch: hipFuncSetAttribute failed\n"); grid = -1; return; }
        int per_cu = 0;
        if (hipOccupancyMaxActiveBlocksPerMultiprocessor(&per_cu, (const void*)mk_fwd, NWAVES * 64, LDS_BYTES) != hipSuccess || per_cu < 1) { fprintf(stderr, "kernel_launch: occupancy query says %d blocks/CU\n", per_cu); }
        (void)hipGetLastError();
        grid = cus;
    }
    if (grid < 0) return;
    if (hipMemsetAsync((char*)d_ws + WS_CTL, 0, CTL_ZERO_BYTES, stream) != hipSuccess) { fprintf(stderr, "kernel_launch: hipMemsetAsync failed\n"); return; }
    Args a{};
    for (int i = 0; i < 20; ++i) a.in[i] = (const float*)d_in[i];
    a.out = (float*)d_out; a.ws = (unsigned char*)d_ws;
    a.ph_lo = 0; a.ph_hi = N_PHASES;
    hipLaunchKernelGGL(mk_fwd, dim3(grid), dim3(NWAVES * 64), LDS_BYTES, stream, a);
}
```
